# Optimizing an MI355X kernel written in HIP

```python
import math
import jax, jax.numpy as jnp
from jax import lax
import numpy as np

D_MODEL = 2048
BATCH = 4
SEQ = 4096
DEPTH = 1
DEC_BATCH = 2
DEC_SEQ = 8192
PAST_LEN = 128

P_DIM = 256
RET_HEADS = 8
RET_DK = 128
RET_DV = 256
RET_CHUNK = 128
ROPE_BASE = 10000.0
ATT_GROUPS = ((128, 1), (512, 4), (2048, 16))
ATT_HEADS = 8
ATT_DH = 128
N_ATT_HEADS = ATT_HEADS * len(ATT_GROUPS)
NEG_INF = -1e30
NUM_BUCKETS = 32
REL_MAX_DIST = 1024
PEER_HEADS = 8
PEER_NKEYS = 128
PEER_N = PEER_NKEYS * PEER_NKEYS
PEER_QDIM = 256
PEER_QHALF = PEER_QDIM // 2
PEER_TOPK = 16
PEER_BLOCK = 64
DN_ALPHA = (2.0 * DEPTH) ** 0.25
DN_BETA = (8.0 * DEPTH) ** -0.25
LN_EPS = 1e-5

RET_QK_W = RET_HEADS * RET_DK
RET_V_W = RET_HEADS * RET_DV
ATT_W = N_ATT_HEADS * ATT_DH
ATT_OUT_W = ATT_HEADS * ATT_DH
SPLITS = (RET_QK_W, RET_QK_W, RET_V_W, RET_V_W, ATT_W, ATT_W, ATT_W, D_MODEL, D_MODEL)
SPLIT_IDX = tuple(int(c) for c in np.cumsum(SPLITS)[:-1])
IN_W = int(sum(SPLITS))

kernel_name = "hybrid_retention_dilated_peer_encoder"

f32 = jnp.float32


def _layernorm(x, g, b):
    xf = x.astype(f32)
    mu = xf.mean(-1, keepdims=True)
    var = jnp.square(xf - mu).mean(-1, keepdims=True)
    y = (xf - mu) * lax.rsqrt(var + LN_EPS) * g.astype(f32) + b.astype(f32)
    return y.astype(x.dtype)


def _rotary(t):
    S = t.shape[1]
    half = t.shape[-1] // 2
    inv = 1.0 / (ROPE_BASE ** jnp.linspace(0.0, 1.0, half, dtype=f32))
    ang = jnp.arange(S, dtype=f32)[:, None] * inv[None, :]
    cos = jnp.cos(ang)[None, :, None, :].astype(t.dtype)
    sin = jnp.sin(ang)[None, :, None, :].astype(t.dtype)
    t1, t2 = t[..., :half], t[..., half:]
    return jnp.concatenate([t1 * cos - t2 * sin, t1 * sin + t2 * cos], axis=-1)


def _retention_dir(q, k, v, log_gamma, strict):
    B, H, S, dk = q.shape
    dv = v.shape[-1]
    n = S // RET_CHUNK
    qc = q.reshape(B, H, n, RET_CHUNK, dk)
    kc = k.reshape(B, H, n, RET_CHUNK, dk)
    vc = v.reshape(B, H, n, RET_CHUNK, dv)
    idx = jnp.arange(RET_CHUNK, dtype=f32)
    diff = idx[:, None] - idx[None, :]
    mask = (diff > 0) if strict else (diff >= 0)
    decay = jnp.where(mask[None], jnp.exp(log_gamma[:, None, None] * jnp.maximum(diff, 0.0)[None]), 0.0)
    scores = jnp.einsum('bhnid,bhnjd->bhnij', qc, kc) * decay[None, :, None]
    o_intra = jnp.einsum('bhnij,bhnjv->bhniv', scores, vc)
    zeta = jnp.exp(log_gamma[:, None] * (RET_CHUNK - 1 - idx)[None])
    kv = jnp.einsum('bhnjd,hj,bhnjv->bhndv', kc, zeta, vc)
    chunk_decay = jnp.exp(log_gamma * RET_CHUNK).astype(kv.dtype)[None, :, None, None]

    def step(R, kv_c):
        return R * chunk_decay + kv_c, R

    _, R_prev = lax.scan(step, jnp.zeros((B, H, dk, dv), kv.dtype), jnp.moveaxis(kv, 2, 0))
    R_prev = jnp.moveaxis(R_prev, 0, 2)
    xi = jnp.exp(log_gamma[:, None] * (idx + 1.0)[None])
    o_cross = jnp.einsum('bhnid,hi,bhndv->bhniv', qc, xi, R_prev)
    return (o_intra + o_cross).reshape(B, H, S, dv)


def _retention_branch(rq, rk, rv, rg, decay_logit):
    B, S, _ = rq.shape
    q = _rotary(rq.reshape(B, S, RET_HEADS, RET_DK))
    k = _rotary(rk.reshape(B, S, RET_HEADS, RET_DK)) * (RET_DK ** -0.5)
    v = rv.reshape(B, S, RET_HEADS, RET_DV)
    q, k, v = [t.transpose(0, 2, 1, 3) for t in (q, k, v)]
    log_gamma = jax.nn.log_sigmoid(decay_logit.astype(f32))
    flip = lambda t: jnp.flip(t, axis=2)
    fwd = _retention_dir(q, k, v, log_gamma[0], False)
    bwd = flip(_retention_dir(flip(q), flip(k), flip(v), log_gamma[1], True))
    o = (fwd + bwd).astype(f32)
    mu = o.mean(-1, keepdims=True)
    var = jnp.square(o - mu).mean(-1, keepdims=True)
    o = (o - mu) * lax.rsqrt(var + LN_EPS)
    o = o.transpose(0, 2, 1, 3).reshape(B, S, RET_V_W).astype(rq.dtype)
    return o * jax.nn.silu(rg)


def _t5_bucket(rel):
    nb = NUM_BUCKETS // 2
    max_exact = nb // 2
    ret = jnp.where(rel > 0, nb, 0)
    n = jnp.abs(rel)
    nf = jnp.maximum(n, 1).astype(f32)
    large = max_exact + (jnp.log(nf / max_exact) / math.log(REL_MAX_DIST / max_exact)
                         * (nb - max_exact)).astype(jnp.int32)
    large = jnp.minimum(large, nb - 1)
    return ret + jnp.where(n < max_exact, n, large)


def _dilated_group(q, k, v, bias_tab, window, dil):
    B, S, H, d = q.shape
    half = window // (2 * dil)
    blk = half
    L = S // dil
    nblk = -(-L // blk)
    Lp = nblk * blk
    pad = Lp - L
    z = B * dil

    def to_res(t):
        return t.reshape(B, L, dil, H, d).transpose(0, 2, 1, 3, 4).reshape(z, L, H, d)

    qb = jnp.pad(to_res(q) * (d ** -0.5), ((0, 0), (0, pad), (0, 0), (0, 0))).reshape(z, nblk, blk, H, d)

    def windows(t):
        tp = jnp.pad(to_res(t), ((0, 0), (blk, pad + blk), (0, 0), (0, 0))).reshape(z, nblk + 2, blk, H, d)
        return jnp.concatenate([tp[:, :-2], tp[:, 1:-1], tp[:, 2:]], axis=2)

    kw, vw = windows(k), windows(v)
    i = jnp.arange(blk)[:, None]
    j = jnp.arange(3 * blk)[None, :]
    off = j - blk - i
    kpos = jnp.arange(nblk)[:, None, None] * blk + (j - blk)[None]
    valid = (jnp.abs(off) <= half)[None] & (kpos >= 0) & (kpos < L)
    bias = bias_tab[_t5_bucket(off * dil)].astype(f32).transpose(2, 0, 1)
    logits = jnp.einsum('znihd,znjhd->znhij', qb, kw).astype(f32) + bias
    logits = jnp.where(valid[None, :, None], logits, NEG_INF)
    m = logits.max(-1, keepdims=True)
    p = jnp.exp(logits - m)
    den = p.sum(-1)
    o = jnp.einsum('znhij,znjhd->znihd', p, vw.astype(f32)) / jnp.swapaxes(den, 2, 3)[..., None]
    lse = jnp.swapaxes(m[..., 0] + jnp.log(den), 2, 3)
    o = o.reshape(z, Lp, H, d)[:, :L].reshape(B, dil, L, H, d).transpose(0, 2, 1, 3, 4).reshape(B, S, H, d)
    lse = lse.reshape(z, Lp, H)[:, :L].reshape(B, dil, L, H).transpose(0, 2, 1, 3).reshape(B, S, H)
    return o, lse


def _dilated_branch(aq, ak, av, rel_bias):
    B, S, _ = aq.shape
    shp = (B, S, len(ATT_GROUPS), ATT_HEADS, ATT_DH)
    q, k, v = aq.reshape(shp), ak.reshape(shp), av.reshape(shp)
    outs, lses = [], []
    for gi, (w, r) in enumerate(ATT_GROUPS):
        o, l = _dilated_group(q[:, :, gi], k[:, :, gi], v[:, :, gi],
                              rel_bias[:, gi * ATT_HEADS:(gi + 1) * ATT_HEADS], w, r)
        outs.append(o)
        lses.append(l)
    wts = jax.nn.softmax(jnp.stack(lses, 0), axis=0)
    o = jnp.sum(wts[..., None] * jnp.stack(outs, 0), axis=0)
    return o.reshape(B, S, ATT_OUT_W).astype(aq.dtype)


def _peer(x, wq, keys, u_tab, v_tab):
    B, S, D = x.shape
    T = B * S
    xt = x.reshape(T, D)
    q = (xt @ wq).reshape(T, PEER_HEADS, 2, PEER_QHALF)
    s = jnp.einsum('thcd,hckd->thck', q, keys).astype(f32)
    s_top, i_top = lax.top_k(s, PEER_TOPK)
    cand = s_top[:, :, 0, :, None] + s_top[:, :, 1, None, :]
    cand_idx = i_top[:, :, 0, :, None] * PEER_NKEYS + i_top[:, :, 1, None, :]
    best, pos = lax.top_k(cand.reshape(T, PEER_HEADS, PEER_TOPK * PEER_TOPK), PEER_TOPK)
    eidx = jnp.take_along_axis(cand_idx.reshape(T, PEER_HEADS, PEER_TOPK * PEER_TOPK), pos, axis=-1)
    g = jax.nn.softmax(best, axis=-1).astype(x.dtype)
    nb = T // PEER_BLOCK

    def blk(args):
        xb, eb, gb = args
        u = u_tab[eb]
        h = jax.nn.gelu(jnp.einsum('td,thkd->thk', xb, u), approximate=False)
        vv = v_tab[eb]
        return jnp.einsum('thk,thkd->td', gb * h, vv)

    out = lax.map(blk, (xt.reshape(nb, PEER_BLOCK, D),
                        eidx.reshape(nb, PEER_BLOCK, PEER_HEADS, PEER_TOPK),
                        g.reshape(nb, PEER_BLOCK, PEER_HEADS, PEER_TOPK)))
    return out.reshape(B, S, D).astype(x.dtype)


def _layer(x, p, w_in, ret_decay_logit, w_ret_o, w_att_o, w_out, rel_bias, ln1_g, ln1_b,
           peer_wq, peer_keys, peer_u, peer_v, w_pe, w_pg, ln2_g, ln2_b):
    proj = x @ w_in
    rq, rk, rv, rg, aq, ak, av, ga, gb = jnp.split(proj, SPLIT_IDX, axis=-1)
    ret = _retention_branch(rq, rk, rv, rg, ret_decay_logit)
    att = _dilated_branch(aq, ak, av, rel_bias)
    merged = jax.nn.sigmoid(ga) * (ret @ w_ret_o) + jax.nn.sigmoid(gb) * (att @ w_att_o)
    h = _layernorm(DN_ALPHA * x + merged @ w_out, ln1_g, ln1_b)
    ff = _peer(h, peer_wq, peer_keys, peer_u, peer_v)
    pe = (p @ w_pe) * jax.nn.sigmoid(h @ w_pg)
    return _layernorm(DN_ALPHA * h + ff + pe, ln2_g, ln2_b)


def setup_inputs(seed: int = 0) -> dict:
    key = jax.random.key(seed)
    ks = jax.random.split(key, 24)
    nrm = lambda k, shape, s: jax.random.normal(k, shape, f32) * s
    x_prompt = nrm(ks[0], (BATCH, SEQ, D_MODEL), 1.0)
    x_sample = nrm(ks[1], (DEC_BATCH, DEC_SEQ, D_MODEL), 1.0)
    p_prompt = nrm(ks[2], (DEPTH, BATCH, SEQ, P_DIM), 1.0)
    p_sample = nrm(ks[3], (DEPTH, DEC_BATCH, DEC_SEQ, P_DIM), 1.0)
    col_scale = jnp.concatenate([jnp.full((n,), s, f32) for n, s in
                                 zip(SPLITS, (1.0, 1.0, DN_BETA, 1.0, 1.0, 1.0, DN_BETA, 1.0, 1.0))])
    w_in = nrm(ks[4], (DEPTH, D_MODEL, IN_W), D_MODEL ** -0.5) * col_scale
    base = jnp.log(2.0 ** (5.0 + jnp.arange(RET_HEADS, dtype=f32)) - 1.0)
    ret_decay_logit = base[None, None, :] + nrm(ks[5], (DEPTH, 2, RET_HEADS), 0.05)
    w_ret_o = nrm(ks[6], (DEPTH, RET_V_W, D_MODEL), DN_BETA * RET_V_W ** -0.5)
    w_att_o = nrm(ks[7], (DEPTH, ATT_OUT_W, D_MODEL), DN_BETA * ATT_OUT_W ** -0.5)
    w_out = nrm(ks[8], (DEPTH, D_MODEL, D_MODEL), DN_BETA * D_MODEL ** -0.5)
    rel_bias = nrm(ks[9], (NUM_BUCKETS, N_ATT_HEADS), 0.2)
    ln1_g = 1.0 + nrm(ks[10], (DEPTH, D_MODEL), 0.02)
    ln1_b = nrm(ks[11], (DEPTH, D_MODEL), 0.02)
    peer_wq = nrm(ks[12], (DEPTH, D_MODEL, PEER_HEADS * PEER_QDIM), D_MODEL ** -0.5)
    peer_keys = nrm(ks[13], (DEPTH, PEER_HEADS, 2, PEER_NKEYS, PEER_QHALF), PEER_QHALF ** -0.5)
    peer_u = nrm(ks[14], (DEPTH, PEER_N, D_MODEL), D_MODEL ** -0.5)
    peer_v = nrm(ks[15], (DEPTH, PEER_N, D_MODEL), DN_BETA * PEER_HEADS ** -0.5)
    w_pe = nrm(ks[16], (DEPTH, P_DIM, D_MODEL), DN_BETA * P_DIM ** -0.5)
    w_pg = nrm(ks[17], (DEPTH, D_MODEL, D_MODEL), D_MODEL ** -0.5)
    ln2_g = 1.0 + nrm(ks[18], (DEPTH, D_MODEL), 0.02)
    ln2_b = nrm(ks[19], (DEPTH, D_MODEL), 0.02)
    return {"x_prompt": x_prompt, "x_sample": x_sample, "p_prompt": p_prompt, "p_sample": p_sample,
            "w_in": w_in, "ret_decay_logit": ret_decay_logit, "w_ret_o": w_ret_o, "w_att_o": w_att_o,
            "w_out": w_out, "rel_bias": rel_bias, "ln1_g": ln1_g, "ln1_b": ln1_b,
            "peer_wq": peer_wq, "peer_keys": peer_keys, "peer_u": peer_u, "peer_v": peer_v,
            "w_pe": w_pe, "w_pg": w_pg, "ln2_g": ln2_g, "ln2_b": ln2_b}


def reference(x_prompt, x_sample, p_prompt, p_sample, w_in, ret_decay_logit, w_ret_o, w_att_o,
              w_out, rel_bias, ln1_g, ln1_b, peer_wq, peer_keys, peer_u, peer_v, w_pe, w_pg,
              ln2_g, ln2_b):
    y_prompt = x_prompt
    y_sample = x_sample
    for i in range(DEPTH):
        y_prompt = _layer(y_prompt, p_prompt[i], w_in[i], ret_decay_logit[i], w_ret_o[i], w_att_o[i],
                          w_out[i], rel_bias, ln1_g[i], ln1_b[i], peer_wq[i], peer_keys[i], peer_u[i],
                          peer_v[i], w_pe[i], w_pg[i], ln2_g[i], ln2_b[i])
        y_sample = _layer(y_sample, p_sample[i], w_in[i], ret_decay_logit[i], w_ret_o[i], w_att_o[i],
                          w_out[i], rel_bias, ln1_g[i], ln1_b[i], peer_wq[i], peer_keys[i], peer_u[i],
                          peer_v[i], w_pe[i], w_pg[i], ln2_g[i], ln2_b[i])
    return (y_prompt, y_sample)
```

```cpp
#include <hip/hip_runtime.h>
#include <hip/hip_cooperative_groups.h>
#include <cstdio>
#include <cmath>
#include <cstring>
namespace cg = cooperative_groups;

typedef unsigned short u16;
typedef short bf16x8 __attribute__((ext_vector_type(8)));
typedef float f32x4 __attribute__((ext_vector_type(4)));
typedef __bf16 bf16x2_t __attribute__((ext_vector_type(2)));
typedef float f32x2_t __attribute__((ext_vector_type(2)));
typedef unsigned u32x4 __attribute__((ext_vector_type(4)));
typedef unsigned u32x2 __attribute__((ext_vector_type(2)));
typedef int i32x4 __attribute__((ext_vector_type(4)));
typedef unsigned char u8;

#define DEV __device__ __forceinline__
#define MFMA(a, b, c) __builtin_amdgcn_mfma_f32_16x16x32_bf16((a), (b), (c), 0, 0, 0)

constexpr int TS = 8192;
constexpr int DM = 2048;
constexpr int NTHR = 256;
constexpr int JSPLIT = 6144;
constexpr int SMEM_BYTES = 74752;
constexpr float DN_ALPHA = 1.189207115002721f;
constexpr float LN_EPS = 1e-5f;
constexpr float QK_SCALE = 0.08838834764831845f;
constexpr float LOG2E = 1.4426950408889634f;

struct Params {
  const float *x_prompt, *x_sample, *p_prompt, *p_sample, *w_in, *decay_logit, *w_ret_o, *w_att_o, *w_out, *rel_bias,
      *ln1_g, *ln1_b, *peer_wq, *peer_keys, *peer_u, *peer_v, *w_pe, *w_pg, *ln2_g, *ln2_b;
  float* out;
  u16 *WretT, *WattT, *WoutT, *WpeT, *keysb, *Ub, *Vb;
  u16 *pb, *Qr, *Kr, *KrT, *VrT, *Rg, *AQ, *AK, *AVT, *GA, *GB, *og, *ret, *att, *merged, *hb, *qb, *peb;
  float *lse, *y, *gw, *biasT, *su, *sv, *sx, *sw, *swpg, *swq, *sh;
  u8 *xq8, *Win8, *Wpg8, *Wq8, *h8;
  u16 *WinTtmp, *WpgTtmp, *WqTtmp;
  int* eidx;
  unsigned* bar;
  float ropec[64];
};

typedef const __attribute__((address_space(3))) Params LParams;
#define PREF LParams&
DEV LParams* launderP(LParams* p) { asm volatile("" : "+v"(p)); return p; }
DEV int tid_() { int t = threadIdx.x; asm volatile("" : "+v"(t)); return t; }
DEV int bid_() { int t = blockIdx.x; asm volatile("" : "+s"(t)); return t; }
DEV int gdim_() { int t = gridDim.x; asm volatile("" : "+s"(t)); return t; }
DEV unsigned pack2(float a, float b) {
  f32x2_t v = {a, b};
  bf16x2_t r = __builtin_convertvector(v, bf16x2_t);
  return __builtin_bit_cast(unsigned, r);
}
DEV float bflo(unsigned u) { return __uint_as_float(u << 16); }
DEV float bfhi(unsigned u) { return __uint_as_float(u & 0xffff0000u); }
DEV u16 f2bf(float a) { return (u16)(pack2(a, 0.f) & 0xffffu); }
DEV float sigm(float x) { return 1.f / (1.f + __expf(-x)); }
DEV float wsum(float v) {
  v += __shfl_xor(v, 32); v += __shfl_xor(v, 16); v += __shfl_xor(v, 8);
  v += __shfl_xor(v, 4);  v += __shfl_xor(v, 2);  v += __shfl_xor(v, 1);
  return v;
}
DEV float log_sigmoid(float x) { return -log1pf(expf(-x)); }

DEV int rowmap(int p, int Sshift, int dl) {
  int seq = p >> Sshift, pp = p & ((1 << Sshift) - 1);
  int Lshift = Sshift - dl;
  int r = pp >> Lshift, l = pp & ((1 << Lshift) - 1);
  return (seq << Sshift) + (l << dl) + r;
}
DEV int posmap(int m, int Sshift, int dl) {
  int seq = m >> Sshift, s = m & ((1 << Sshift) - 1);
  int Lshift = Sshift - dl;
  return (seq << Sshift) + ((s & ((1 << dl) - 1)) << Lshift) + (s >> dl);
}

DEV const float* x_slab(PREF P, int slab) {
  return slab < 2 ? P.x_prompt + (size_t)slab * TS * DM : P.x_sample + (size_t)(slab - 2) * TS * DM;
}
DEV const float* p_slab(PREF P, int slab) {
  return slab < 2 ? P.p_prompt + (size_t)slab * TS * 256 : P.p_sample + (size_t)(slab - 2) * TS * 256;
}

__device__ void convert_bf16(const float* __restrict__ src, u16* __restrict__ dst, size_t n8) {
  for (size_t i = (size_t)bid_() * NTHR + tid_(); i < n8; i += (size_t)gdim_() * NTHR) {
    float4 a = ((const float4*)src)[2 * i], b = ((const float4*)src)[2 * i + 1];
    uint4 o;
    o.x = pack2(a.x, a.y); o.y = pack2(a.z, a.w); o.z = pack2(b.x, b.y); o.w = pack2(b.z, b.w);
    ((uint4*)dst)[i] = o;
  }
}

DEV float wmax(float v) {
  v = fmaxf(v, __shfl_xor(v, 32)); v = fmaxf(v, __shfl_xor(v, 16)); v = fmaxf(v, __shfl_xor(v, 8));
  v = fmaxf(v, __shfl_xor(v, 4));  v = fmaxf(v, __shfl_xor(v, 2));  v = fmaxf(v, __shfl_xor(v, 1));
  return v;
}
DEV int wsum_i(int v) {
  v += __shfl_xor(v, 32); v += __shfl_xor(v, 16); v += __shfl_xor(v, 8);
  v += __shfl_xor(v, 4);  v += __shfl_xor(v, 2);  v += __shfl_xor(v, 1);
  return v;
}
DEV unsigned q4(float a, float b, float c, float d, float inv, int off) {
  int qa = (int)rintf(a * inv), qb = (int)rintf(b * inv), qc = (int)rintf(c * inv), qd = (int)rintf(d * inv);
  qa = min(max(qa, -127), 127) + off; qb = min(max(qb, -127), 127) + off;
  qc = min(max(qc, -127), 127) + off; qd = min(max(qd, -127), 127) + off;
  return (unsigned)(qa & 255) | ((unsigned)(qb & 255) << 8) | ((unsigned)(qc & 255) << 16) | ((unsigned)(qd & 255) << 24);
}
__device__ void quant_rows_f32(const float* __restrict__ src, unsigned char* __restrict__ dst, float* __restrict__ scales,
                               int nrows, int off) {
  const int lane = tid_() & 63, wid = tid_() >> 6;
  for (int row = bid_() * 4 + wid; row < nrows; row += gdim_() * 4) {
    const float* r = src + (size_t)row * 2048 + lane * 16;
    float v[32];
#pragma unroll
    for (int hf = 0; hf < 2; ++hf)
#pragma unroll
      for (int c = 0; c < 4; ++c) {
        float4 x = *(const float4*)(r + hf * 1024 + c * 4);
        v[hf * 16 + c * 4 + 0] = x.x; v[hf * 16 + c * 4 + 1] = x.y; v[hf * 16 + c * 4 + 2] = x.z; v[hf * 16 + c * 4 + 3] = x.w;
      }
    float am = 0.f;
#pragma unroll
    for (int e = 0; e < 32; ++e) am = fmaxf(am, fabsf(v[e]));
    am = wmax(am);
    const float sc = am > 0.f ? am * (1.f / 127.f) : 1.f;
    const float inv = 1.f / sc;
#pragma unroll
    for (int hf = 0; hf < 2; ++hf) {
      u32x4 o;
      o.x = q4(v[hf * 16 + 0], v[hf * 16 + 1], v[hf * 16 + 2], v[hf * 16 + 3], inv, off);
      o.y = q4(v[hf * 16 + 4], v[hf * 16 + 5], v[hf * 16 + 6], v[hf * 16 + 7], inv, off);
      o.z = q4(v[hf * 16 + 8], v[hf * 16 + 9], v[hf * 16 + 10], v[hf * 16 + 11], inv, off);
      o.w = q4(v[hf * 16 + 12], v[hf * 16 + 13], v[hf * 16 + 14], v[hf * 16 + 15], inv, off);
      *(u32x4*)(dst + (size_t)row * 2048 + hf * 1024 + lane * 16) = o;
    }
    if (lane == 0) scales[row] = sc;
  }
}

__device__ void quant_rows_bf16(const u16* __restrict__ src, u8* __restrict__ dst, float* __restrict__ scales, int nrows) {
  const int lane = tid_() & 63, wid = tid_() >> 6;
  for (int row = bid_() * 4 + wid; row < nrows; row += gdim_() * 4) {
    const u16* r = src + (size_t)row * 2048 + lane * 16;
    float v[32];
    {
      u32x4 a = *(const u32x4*)r, b = *(const u32x4*)(r + 8), c = *(const u32x4*)(r + 1024), d = *(const u32x4*)(r + 1032);
      v[0] = bflo(a.x); v[1] = bfhi(a.x); v[2] = bflo(a.y); v[3] = bfhi(a.y); v[4] = bflo(a.z); v[5] = bfhi(a.z); v[6] = bflo(a.w); v[7] = bfhi(a.w);
      v[8] = bflo(b.x); v[9] = bfhi(b.x); v[10] = bflo(b.y); v[11] = bfhi(b.y); v[12] = bflo(b.z); v[13] = bfhi(b.z); v[14] = bflo(b.w); v[15] = bfhi(b.w);
      v[16] = bflo(c.x); v[17] = bfhi(c.x); v[18] = bflo(c.y); v[19] = bfhi(c.y); v[20] = bflo(c.z); v[21] = bfhi(c.z); v[22] = bflo(c.w); v[23] = bfhi(c.w);
      v[24] = bflo(d.x); v[25] = bfhi(d.x); v[26] = bflo(d.y); v[27] = bfhi(d.y); v[28] = bflo(d.z); v[29] = bfhi(d.z); v[30] = bflo(d.w); v[31] = bfhi(d.w);
    }
    float am = 0.f;
#pragma unroll
    for (int e = 0; e < 32; ++e) am = fmaxf(am, fabsf(v[e]));
    am = wmax(am);
    const float sc = am > 0.f ? am * (1.f / 127.f) : 1.f;
    const float inv = 1.f / sc;
#pragma unroll
    for (int hf = 0; hf < 2; ++hf) {
      u32x4 o;
      o.x = q4(v[hf * 16 + 0], v[hf * 16 + 1], v[hf * 16 + 2], v[hf * 16 + 3], inv, 0);
      o.y = q4(v[hf * 16 + 4], v[hf * 16 + 5], v[hf * 16 + 6], v[hf * 16 + 7], inv, 0);
      o.z = q4(v[hf * 16 + 8], v[hf * 16 + 9], v[hf * 16 + 10], v[hf * 16 + 11], inv, 0);
      o.w = q4(v[hf * 16 + 12], v[hf * 16 + 13], v[hf * 16 + 14], v[hf * 16 + 15], inv, 0);
      *(u32x4*)(dst + (size_t)row * 2048 + hf * 1024 + lane * 16) = o;
    }
    if (lane == 0) scales[row] = sc;
  }
}

__device__ void transpose_convert(const float* __restrict__ src, int K, int N, u16* __restrict__ dst, char* smem) {
  float* tile = (float*)smem;
  const int tilesN = N >> 6, ntiles = (K >> 6) * tilesN;
  const int tid = tid_();
  for (int t = bid_(); t < ntiles; t += gdim_()) {
    const int k0 = (t / tilesN) << 6, n0 = (t % tilesN) << 6;
    __syncthreads();
    const int ty = tid >> 4, tx = tid & 15;
#pragma unroll
    for (int pp = 0; pp < 4; ++pp) {
      int k = ty + 16 * pp;
      float4 v = *(const float4*)(src + (size_t)(k0 + k) * N + n0 + tx * 4);
      float* d = tile + k * 65 + tx * 4;
      d[0] = v.x; d[1] = v.y; d[2] = v.z; d[3] = v.w;
    }
    __syncthreads();
    const int n = tid >> 2, ks = (tid & 3) * 16;
    unsigned o[8];
#pragma unroll
    for (int e = 0; e < 8; ++e) o[e] = pack2(tile[(ks + 2 * e) * 65 + n], tile[(ks + 2 * e + 1) * 65 + n]);
    uint4* d = (uint4*)(dst + (size_t)(n0 + n) * K + k0 + ks);
    d[0] = make_uint4(o[0], o[1], o[2], o[3]);
    d[1] = make_uint4(o[4], o[5], o[6], o[7]);
  }
}

DEV f32x4 mma_step(bf16x8 a, bf16x8 b, f32x4 c) { return MFMA(a, b, c); }
DEV i32x4 mma_step(i32x4 a, i32x4 b, i32x4 c) { return __builtin_amdgcn_mfma_i32_16x16x64_i8(a, b, c, 0, 0, 0); }

template <class FragT, class AccT>
DEV void gemm_core_t(const char* __restrict__ A, size_t lda_bytes, const char* __restrict__ Bt, size_t ldb_bytes, int kbytes,
                     int m0, int n0, int Sshift, int dl, char* smem, AccT (&acc)[4][4]) {
  const int tid = tid_(), lane = tid & 63, wid = tid >> 6, wm = wid >> 1, wn = wid & 1;
  const int l15 = lane & 15, q = lane >> 4;
  const int srow = lane >> 3, schunk = (lane & 7) ^ (lane >> 3);
  const char* ap[4];
  const char* bp[4];
#pragma unroll
  for (int u = 0; u < 4; ++u) {
    int r = (wid * 4 + u) * 8 + srow;
    int ar = rowmap(m0 + r, Sshift, dl);
    ap[u] = A + (size_t)ar * lda_bytes + schunk * 16;
    bp[u] = Bt + (size_t)(n0 + r) * ldb_bytes + schunk * 16;
  }
#pragma unroll
  for (int i = 0; i < 4; ++i)
#pragma unroll
    for (int j = 0; j < 4; ++j) acc[i][j] = AccT{0, 0, 0, 0};
  const int nk = kbytes >> 7;
  __syncthreads();
#pragma unroll
  for (int u = 0; u < 4; ++u) {
    __builtin_amdgcn_global_load_lds((const unsigned*)ap[u], (unsigned*)(smem + (wid * 4 + u) * 1024 + lane * 16), 16, 0, 0);
    __builtin_amdgcn_global_load_lds((const unsigned*)bp[u], (unsigned*)(smem + 16384 + (wid * 4 + u) * 1024 + lane * 16), 16, 0, 0);
  }
  const unsigned sbase = (unsigned)(unsigned long)((__attribute__((address_space(3))) char*)smem);
  const unsigned sq0 = (unsigned)((q ^ (l15 & 7)) << 4);
  const unsigned a0 = sbase + (unsigned)((wm * 64 + l15) * 128) + sq0;
  const unsigned b0 = sbase + 16384u + (unsigned)((wn * 32 + l15) * 128) + sq0;
  asm volatile("s_waitcnt vmcnt(0)" ::: "memory");
  __syncthreads();
  for (int kt = 0; kt < nk; ++kt) {
    const unsigned so = (unsigned)(kt & 1) * 32768u;
    char* nxt = smem + ((kt + 1) & 1) * 32768;
    if (kt + 1 < nk) {
#pragma unroll
      for (int u = 0; u < 4; ++u) {
        __builtin_amdgcn_global_load_lds((const unsigned*)(ap[u] + (size_t)(kt + 1) * 128), (unsigned*)(nxt + (wid * 4 + u) * 1024 + lane * 16), 16, 0, 0);
        __builtin_amdgcn_global_load_lds((const unsigned*)(bp[u] + (size_t)(kt + 1) * 128), (unsigned*)(nxt + 16384 + (wid * 4 + u) * 1024 + lane * 16), 16, 0, 0);
      }
    }
    FragT xa[2][4], wb[2][4];
    asm volatile(
        "ds_read_b128 %0, %16\n\t"
        "ds_read_b128 %1, %16 offset:2048\n\t"
        "ds_read_b128 %2, %16 offset:4096\n\t"
        "ds_read_b128 %3, %16 offset:6144\n\t"
        "ds_read_b128 %4, %18\n\t"
        "ds_read_b128 %5, %18 offset:2048\n\t"
        "ds_read_b128 %6, %18 offset:8192\n\t"
        "ds_read_b128 %7, %18 offset:10240\n\t"
        "ds_read_b128 %8, %17\n\t"
        "ds_read_b128 %9, %17 offset:2048\n\t"
        "ds_read_b128 %10, %17 offset:4096\n\t"
        "ds_read_b128 %11, %17 offset:6144\n\t"
        "ds_read_b128 %12, %19\n\t"
        "ds_read_b128 %13, %19 offset:2048\n\t"
        "ds_read_b128 %14, %19 offset:8192\n\t"
        "ds_read_b128 %15, %19 offset:10240\n\t"
        "s_waitcnt lgkmcnt(8)"
        : "=&v"(xa[0][0]), "=&v"(xa[0][1]), "=&v"(xa[0][2]), "=&v"(xa[0][3]), "=&v"(wb[0][0]), "=&v"(wb[0][1]), "=&v"(wb[0][2]),
          "=&v"(wb[0][3]), "=&v"(xa[1][0]), "=&v"(xa[1][1]), "=&v"(xa[1][2]), "=&v"(xa[1][3]), "=&v"(wb[1][0]), "=&v"(wb[1][1]),
          "=&v"(wb[1][2]), "=&v"(wb[1][3])
        : "v"(a0 + so), "v"((a0 ^ 64u) + so), "v"(b0 + so), "v"((b0 ^ 64u) + so)
        : "memory");
    __builtin_amdgcn_s_setprio(1);
#pragma unroll
    for (int i = 0; i < 4; ++i)
#pragma unroll
      for (int j = 0; j < 4; ++j) acc[i][j] = mma_step(wb[0][j], xa[0][i], acc[i][j]);
    asm volatile("s_waitcnt lgkmcnt(0)"
                 : "+v"(xa[1][0]), "+v"(xa[1][1]), "+v"(xa[1][2]), "+v"(xa[1][3]), "+v"(wb[1][0]), "+v"(wb[1][1]), "+v"(wb[1][2]),
                   "+v"(wb[1][3]), "+v"(acc[0][0]), "+v"(acc[0][1]), "+v"(acc[0][2]), "+v"(acc[0][3]), "+v"(acc[1][0]),
                   "+v"(acc[1][1]), "+v"(acc[1][2]), "+v"(acc[1][3]), "+v"(acc[2][0]), "+v"(acc[2][1]), "+v"(acc[2][2]),
                   "+v"(acc[2][3]), "+v"(acc[3][0]), "+v"(acc[3][1]), "+v"(acc[3][2]), "+v"(acc[3][3])
                 :
                 : "memory");
#pragma unroll
    for (int i = 0; i < 4; ++i)
#pragma unroll
      for (int j = 0; j < 4; ++j) acc[i][j] = mma_step(wb[1][j], xa[1][i], acc[i][j]);
    __builtin_amdgcn_s_setprio(0);
    asm volatile("s_waitcnt vmcnt(0)"
                 : "+v"(acc[0][0]), "+v"(acc[0][1]), "+v"(acc[0][2]), "+v"(acc[0][3]), "+v"(acc[1][0]), "+v"(acc[1][1]),
                   "+v"(acc[1][2]), "+v"(acc[1][3]), "+v"(acc[2][0]), "+v"(acc[2][1]), "+v"(acc[2][2]), "+v"(acc[2][3]),
                   "+v"(acc[3][0]), "+v"(acc[3][1]), "+v"(acc[3][2]), "+v"(acc[3][3])
                 :
                 : "memory");
    __syncthreads();
  }
}

DEV void gemm_core(const u16* __restrict__ A, int lda, const u16* __restrict__ Bt, int ldb, int K, int m0, int n0,
                   int Sshift, int dl, char* smem, f32x4 (&acc)[4][4]) {
  gemm_core_t<bf16x8, f32x4>((const char*)A, (size_t)lda * 2, (const char*)Bt, (size_t)ldb * 2, K * 2, m0, n0, Sshift, dl, smem, acc);
}
DEV void gemm_core_i8(const u8* __restrict__ A, int lda, const u8* __restrict__ Bt, int ldb, int K, int m0, int n0,
                      int Sshift, int dl, char* smem, i32x4 (&acc)[4][4]) {
  gemm_core_t<i32x4, i32x4>((const char*)A, (size_t)lda, (const char*)Bt, (size_t)ldb, K, m0, n0, Sshift, dl, smem, acc);
}

DEV void tile_map(int t, int ntx, int& mt, int& nt) {
  int x = t & 7, u = t >> 3;
  int grp = u / (8 * ntx), rem = u % (8 * ntx);
  nt = x * ntx + (rem >> 3);
  mt = grp * 8 + (rem & 7);
}

DEV void store_nat(u16* buf, int ld, int row, int col, f32x4 v) {
  uint2 o; o.x = pack2(v[0], v[1]); o.y = pack2(v[2], v[3]);
  *(uint2*)(buf + (size_t)row * ld + col) = o;
}
DEV void store_tr(u16* buf, int col, int m, f32x4 v) {
#pragma unroll
  for (int r = 0; r < 4; ++r) buf[(size_t)(col + r) * TS + m] = f2bf(v[r]);
}

__device__ __forceinline__ void phase_gemm1(PREF P, int slab, char* smem) {
  const int Sshift = slab < 2 ? 12 : 13;
  const int lane = tid_() & 63, wid = tid_() >> 6, wm = wid >> 1, wn = wid & 1, l15 = lane & 15, q = lane >> 4;
  for (int t = bid_(); t < 64 * 152; t += gdim_()) {
    int mt, nt;
    tile_map(t, 19, mt, nt);
    const int m0 = mt * 128, n0 = nt * 128;
    int region, dl = 0;
    if (n0 < 1024) region = 0;
    else if (n0 < 2048) region = 1;
    else if (n0 < 4096) region = 2;
    else if (n0 < 6144) region = 3;
    else if (n0 < 9216) region = 4;
    else if (n0 < 12288) region = 5;
    else if (n0 < 15360) region = 6;
    else if (n0 < 17408) region = 7;
    else region = 8;
    if (region >= 4 && region <= 6) dl = 2 * ((n0 - (6144 + (region - 4) * 3072)) >> 10);
    f32x4 acc[4][4];
    {
      i32x4 iacc[4][4];
      gemm_core_i8(P.xq8, DM, P.Win8, DM, DM, m0, n0, Sshift, dl, smem, iacc);
#pragma unroll
      for (int i = 0; i < 4; ++i) {
        const float sxr = P.sx[rowmap(m0 + wm * 64 + i * 16 + l15, Sshift, dl)];
#pragma unroll
        for (int j = 0; j < 4; ++j) {
          const float4 swc = *(const float4*)(P.sw + n0 + (j & 1) * 16 + wn * 32 + (j >> 1) * 64 + q * 4);
          acc[i][j][0] = (float)iacc[i][j][0] * sxr * swc.x; acc[i][j][1] = (float)iacc[i][j][1] * sxr * swc.y;
          acc[i][j][2] = (float)iacc[i][j][2] * sxr * swc.z; acc[i][j][3] = (float)iacc[i][j][3] * sxr * swc.w;
        }
      }
    }
    if (region <= 1) {
#pragma unroll
      for (int i = 0; i < 4; ++i) {
        const int row = m0 + wm * 64 + i * 16 + l15;
        const float s = (float)(row & ((1 << Sshift) - 1));
#pragma unroll
        for (int jj = 0; jj < 2; ++jj)
#pragma unroll
          for (int r = 0; r < 4; ++r) {
            const int d = jj * 16 + wn * 32 + q * 4 + r;
            float fr = __builtin_amdgcn_fractf(s * P.ropec[d]);
            float cs = __builtin_amdgcn_cosf(fr), sn = __builtin_amdgcn_sinf(fr);
            float t1 = acc[i][jj][r], t2 = acc[i][jj + 2][r];
            float o1 = t1 * cs - t2 * sn, o2 = t1 * sn + t2 * cs;
            if (region == 1) { o1 *= QK_SCALE; o2 *= QK_SCALE; }
            acc[i][jj][r] = o1;
            acc[i][jj + 2][r] = o2;
          }
      }
    }
    u16* nbuf = nullptr; int nld = 0, ncol = 0;
    u16* tbuf = nullptr; int tcol = 0;
    switch (region) {
      case 0: nbuf = P.Qr; nld = 1024; ncol = n0; break;
      case 1: nbuf = P.Kr; nld = 1024; ncol = n0 - 1024; tbuf = P.KrT; tcol = n0 - 1024; break;
      case 2: tbuf = P.VrT; tcol = n0 - 2048; break;
      case 3: nbuf = P.Rg; nld = 2048; ncol = n0 - 4096; break;
      case 4: nbuf = P.AQ; nld = 3072; ncol = n0 - 6144; break;
      case 5: nbuf = P.AK; nld = 3072; ncol = n0 - 9216; break;
      case 6: tbuf = P.AVT; tcol = n0 - 12288; break;
      default: break;
    }
    if (region == 4) {
#pragma unroll
      for (int i = 0; i < 4; ++i)
#pragma unroll
        for (int j = 0; j < 4; ++j) acc[i][j] = acc[i][j] * QK_SCALE;
    }
    const int tid = tid_();
    if (region >= 7) {
      u8* gb8 = (u8*)(region == 7 ? P.GA : P.GB);
      const int gcol = n0 - (region == 7 ? 15360 : 17408);
#pragma unroll
      for (int i = 0; i < 4; ++i)
#pragma unroll
        for (int j = 0; j < 4; ++j) {
          const int rl = wm * 64 + i * 16 + l15, cl = (j & 1) * 16 + wn * 32 + (j >> 1) * 64 + q * 4;
          const unsigned b0 = (unsigned)(sigm(acc[i][j][0]) * 255.f + 0.5f), b1 = (unsigned)(sigm(acc[i][j][1]) * 255.f + 0.5f);
          const unsigned b2 = (unsigned)(sigm(acc[i][j][2]) * 255.f + 0.5f), b3 = (unsigned)(sigm(acc[i][j][3]) * 255.f + 0.5f);
          *(unsigned*)(smem + rl * 144 + cl) = b0 | (b1 << 8) | (b2 << 16) | (b3 << 24);
        }
      __syncthreads();
#pragma unroll
      for (int k = 0; k < 4; ++k) {
        const int chunk = tid + 256 * k, rl = chunk >> 3, c16 = chunk & 7;
        u32x4 d = *(const u32x4*)(smem + rl * 144 + c16 * 16);
        __builtin_nontemporal_store(d, (u32x4*)(gb8 + (size_t)(m0 + rl) * 2048 + gcol + c16 * 16));
      }
    }
    if (nbuf) {
#pragma unroll
      for (int i = 0; i < 4; ++i)
#pragma unroll
        for (int j = 0; j < 4; ++j) {
          const int rl = wm * 64 + i * 16 + l15, cl = (j & 1) * 16 + wn * 32 + (j >> 1) * 64 + q * 4;
          u32x2 o; o.x = pack2(acc[i][j][0], acc[i][j][1]); o.y = pack2(acc[i][j][2], acc[i][j][3]);
          *(u32x2*)(smem + rl * 272 + cl * 2) = o;
        }
      __syncthreads();
#pragma unroll
      for (int k = 0; k < 8; ++k) {
        const int chunk = tid + 256 * k, rl = chunk >> 4, c16 = chunk & 15;
        u32x4 d = *(const u32x4*)(smem + rl * 272 + c16 * 16);
        __builtin_nontemporal_store(d, (u32x4*)(nbuf + (size_t)(m0 + rl) * nld + ncol + c16 * 8));
      }
      if (tbuf) __syncthreads();
    }
    if (tbuf) {
#pragma unroll
      for (int i = 0; i < 4; ++i)
#pragma unroll
        for (int j = 0; j < 4; ++j) {
          const int rl = wm * 64 + i * 16 + l15, cl = (j & 1) * 16 + wn * 32 + (j >> 1) * 64 + q * 4;
#pragma unroll
          for (int r = 0; r < 4; ++r) *(u16*)(smem + (cl + r) * 272 + rl * 2) = f2bf(acc[i][j][r]);
        }
      __syncthreads();
#pragma unroll
      for (int k = 0; k < 8; ++k) {
        const int chunk = tid + 256 * k, cl = chunk >> 4, c16 = chunk & 15;
        u32x4 d = *(const u32x4*)(smem + cl * 272 + c16 * 16);
        __builtin_nontemporal_store(d, (u32x4*)(tbuf + (size_t)(tcol + cl) * TS + m0 + c16 * 8));
      }
    }
  }
}

template <class F>
DEV void dma_rows256(F rowptr, int nrows, char* lds) {
  const int lane = tid_() & 63, wid = tid_() >> 6;
  for (int blk = wid; blk < (nrows >> 2); blk += 4) {
    const int row = blk * 4 + (lane >> 4);
    const int c = (lane & 15) ^ (row & 15);
    const u16* src = rowptr(row) + c * 8;
    __builtin_amdgcn_global_load_lds((const unsigned*)src, (unsigned*)(lds + blk * 1024 + lane * 16), 16, 0, 0);
  }
}
DEV bf16x8 rd128(const char* lds, int row, int chunk) {
  return *(const bf16x8*)(lds + row * 256 + ((chunk ^ (row & 15)) << 4));
}
DEV u32x2 rd64(const char* lds, int row, int byteoff) {
  return *(const u32x2*)(lds + row * 256 + ((((byteoff >> 4)) ^ (row & 15)) << 4) + (byteoff & 15));
}
#define DMA_WAIT_SYNC() do { asm volatile("s_waitcnt vmcnt(0)" ::: "memory"); __syncthreads(); } while (0)

__device__ __forceinline__ void ret_kv_item(PREF P, int w, u16* ST, char* smem) {
  const int lane = tid_() & 63, wid = tid_() >> 6, l15 = lane & 15, q = lane >> 4;
  const int dir = w & 1, h = (w >> 1) & 7, n = w >> 4;
  const int tok0 = n * 128;
  const float l2 = log_sigmoid(P.decay_logit[dir * 8 + h]) * LOG2E;
  __syncthreads();
  {
    const u16* kt = P.KrT + (size_t)(h * 128) * TS + tok0;
    dma_rows256([&](int row) { return kt + (size_t)row * TS; }, 128, smem);
  }
  u32x4 vraw[4][4];
  {
    const u16* vbase = P.VrT + (size_t)(h * 256 + wid * 64 + l15) * TS + tok0 + q * 8;
#pragma unroll
    for (int kk = 0; kk < 4; ++kk)
#pragma unroll
      for (int jd = 0; jd < 4; ++jd) vraw[kk][jd] = *(const u32x4*)(vbase + (size_t)jd * 16 * TS + kk * 32);
  }
  f32x4 acc[8][4];
#pragma unroll
  for (int a = 0; a < 8; ++a)
#pragma unroll
    for (int b = 0; b < 4; ++b) acc[a][b] = f32x4{0.f, 0.f, 0.f, 0.f};
  DMA_WAIT_SYNC();
#pragma unroll
  for (int kk = 0; kk < 4; ++kk) {
    const int tb = kk * 32 + q * 8;
    float z[8];
#pragma unroll
    for (int e = 0; e < 8; ++e) {
      int t = tb + e;
      z[e] = __builtin_amdgcn_exp2f(l2 * (float)(dir == 0 ? 127 - t : t));
    }
    bf16x8 vb[4];
#pragma unroll
    for (int jd = 0; jd < 4; ++jd) {
      u32x4 raw = vraw[kk][jd];
      u32x4 o;
      o.x = pack2(bflo(raw.x) * z[0], bfhi(raw.x) * z[1]);
      o.y = pack2(bflo(raw.y) * z[2], bfhi(raw.y) * z[3]);
      o.z = pack2(bflo(raw.z) * z[4], bfhi(raw.z) * z[5]);
      o.w = pack2(bflo(raw.w) * z[6], bfhi(raw.w) * z[7]);
      vb[jd] = __builtin_bit_cast(bf16x8, o);
    }
#pragma unroll
    for (int ik = 0; ik < 8; ++ik) {
      bf16x8 ka = rd128(smem, ik * 16 + l15, kk * 4 + q);
#pragma unroll
      for (int jd = 0; jd < 4; ++jd) acc[ik][jd] = MFMA(ka, vb[jd], acc[ik][jd]);
    }
  }
  u16* dst = ST + ((size_t)((n * 8 + h) * 2 + dir)) * 32768;
#pragma unroll
  for (int ik = 0; ik < 8; ++ik)
#pragma unroll
    for (int jd = 0; jd < 4; ++jd) {
      uint2 o; o.x = pack2(acc[ik][jd][0], acc[ik][jd][1]); o.y = pack2(acc[ik][jd][2], acc[ik][jd][3]);
      *(uint2*)(dst + (size_t)(wid * 64 + jd * 16 + l15) * 128 + ik * 16 + q * 4) = o;
    }
}

__device__ __forceinline__ void attn_item(PREF P, int w, int Sshift, char* smem) {
  const int lane = tid_() & 63, wid = tid_() >> 6, l15 = lane & 15, q = lane >> 4;
  const int qb = w & 127, hs = (w >> 7) & 7, gi = w >> 10;
  const int dl = gi * 2, Lshift = Sshift - dl, L = 1 << Lshift;
  const int p0 = qb * 64, l0 = p0 & (L - 1), pbase = p0 - l0;
  const int hcol = (gi * 8 + hs) * 128;
  const int li = l0 + wid * 16 + l15;
  char* KW = smem;
  char* VH = smem + 49152;
  auto dma_vhalf = [&](char* dstb, int half) {
    for (int ins = wid; ins < 25; ins += 4) {
      const int sl = ins * 64 + lane;
      const int row = sl / 25;
      int cp = sl - row * 25;
      if (cp == 24) cp = 0;
      int l = l0 - 64 + cp * 8;
      if (l < 0 || l >= L) l = 0;
      const u16* src = P.AVT + (size_t)(hcol + half * 64 + row) * TS + pbase + l;
      __builtin_amdgcn_global_load_lds((const unsigned*)src, (unsigned*)(dstb + ins * 1024 + lane * 16), 16, 0, 0);
    }
  };
  __syncthreads();
  {
    const u16* kb = P.AK + (size_t)pbase * 3072 + hcol;
    dma_rows256([&](int row) { int l = min(max(l0 - 64 + row, 0), L - 1); return kb + (size_t)l * 3072; }, 192, KW);
  }
  dma_vhalf(VH, 0);
  bf16x8 qf[4];
  {
    const u16* qrow = P.AQ + (size_t)(pbase + li) * 3072 + hcol + q * 8;
#pragma unroll
    for (int kd = 0; kd < 4; ++kd) qf[kd] = *(const bf16x8*)(qrow + kd * 32);
  }
  const int kstart = l0 + wid * 16 - 64;
  const float* brow = P.biasT + (gi * 8 + hs) * 129 + 64;
  float bv[10][4];
#pragma unroll
  for (int jt = 0; jt < 10; ++jt)
#pragma unroll
    for (int r = 0; r < 4; ++r) {
      int off = kstart + jt * 16 + q * 4 + r - li;
      bv[jt][r] = brow[min(max(off, -64), 64)];
    }
  DMA_WAIT_SYNC();
  f32x4 sT[10];
#pragma unroll
  for (int jt = 0; jt < 10; ++jt) {
    const int krow = min(wid * 16 + jt * 16 + l15, 191);
    f32x4 sa = {0.f, 0.f, 0.f, 0.f};
#pragma unroll
    for (int kd = 0; kd < 4; ++kd) sa = MFMA(rd128(KW, krow, kd * 4 + q), qf[kd], sa);
    sT[jt] = sa;
  }
  __syncthreads();
  dma_vhalf(KW, 1);
  float mx = -1e30f;
#pragma unroll
  for (int jt = 0; jt < 10; ++jt)
#pragma unroll
    for (int r = 0; r < 4; ++r) {
      int lk = kstart + jt * 16 + q * 4 + r;
      int off = lk - li;
      bool valid = (off >= -64) && (off <= 64) && (lk >= 0) && (lk < L);
      float lg = valid ? sT[jt][r] + bv[jt][r] : -1e30f;
      sT[jt][r] = lg;
      mx = fmaxf(mx, lg);
    }
  mx = fmaxf(mx, __shfl_xor(mx, 16));
  mx = fmaxf(mx, __shfl_xor(mx, 32));
  float den = 0.f;
#pragma unroll
  for (int jt = 0; jt < 10; ++jt)
#pragma unroll
    for (int r = 0; r < 4; ++r) {
      float lg = sT[jt][r];
      float p = (lg > -1e29f) ? __expf(lg - mx) : 0.f;
      sT[jt][r] = p;
      den += p;
    }
  den += __shfl_xor(den, 16);
  den += __shfl_xor(den, 32);
  bf16x8 pf[5];
#pragma unroll
  for (int j2 = 0; j2 < 5; ++j2) {
    u32x4 pp;
    pp.x = pack2(sT[2 * j2][0], sT[2 * j2][1]);
    pp.y = pack2(sT[2 * j2][2], sT[2 * j2][3]);
    pp.z = pack2(sT[2 * j2 + 1][0], sT[2 * j2 + 1][1]);
    pp.w = pack2(sT[2 * j2 + 1][2], sT[2 * j2 + 1][3]);
    pf[j2] = __builtin_bit_cast(bf16x8, pp);
  }
  const float inv = 1.f / den;
  u16* orow = P.og + ((size_t)gi * TS + pbase + li) * 1024 + hs * 128 + q * 4;
#pragma unroll 1
  for (int half = 0; half < 2; ++half) {
    const char* vb = half == 0 ? VH : KW;
    if (half == 1) DMA_WAIT_SYNC();
    f32x4 oT[4];
#pragma unroll
    for (int d = 0; d < 4; ++d) oT[d] = f32x4{0.f, 0.f, 0.f, 0.f};
#pragma unroll
    for (int j2 = 0; j2 < 5; ++j2) {
      int ia = wid * 16 + j2 * 32 + q * 4;
      int ib = ia + 16;
      if (ia >= 192) ia = 0;
      if (ib >= 192) ib = 0;
#pragma unroll
      for (int dvt = 0; dvt < 4; ++dvt) {
        const char* vrow = vb + (dvt * 16 + l15) * 400;
        u32x2 a0 = *(const u32x2*)(vrow + ia * 2), a1 = *(const u32x2*)(vrow + ib * 2);
        u32x4 vv = {a0.x, a0.y, a1.x, a1.y};
        oT[dvt] = MFMA(__builtin_bit_cast(bf16x8, vv), pf[j2], oT[dvt]);
      }
    }
#pragma unroll
    for (int dvt = 0; dvt < 4; ++dvt) {
      uint2 o;
      o.x = pack2(oT[dvt][0] * inv, oT[dvt][1] * inv);
      o.y = pack2(oT[dvt][2] * inv, oT[dvt][3] * inv);
      *(uint2*)(orow + half * 64 + dvt * 16) = o;
    }
  }
  if (q == 0) P.lse[((size_t)gi * TS + pbase + li) * 8 + hs] = mx + logf(den);
}

__device__ __forceinline__ void phase_scan(PREF P, int slab, u16* ST) {
  const int Sshift = slab < 2 ? 12 : 13;
  const int nseq = TS >> Sshift, nC = 1 << (Sshift - 7);
  const int nitems = nseq * 16 * 4096;
  for (int idx = bid_() * NTHR + tid_(); idx < nitems; idx += gdim_() * NTHR) {
    const int e8 = idx & 4095, hd = (idx >> 12) & 15, seq = idx >> 16;
    const int dir = hd & 1, h = hd >> 1;
    const float dec = expf(log_sigmoid(P.decay_logit[dir * 8 + h]) * 128.f);
    float R[8];
#pragma unroll
    for (int e = 0; e < 8; ++e) R[e] = 0.f;
    u16* base = ST + (size_t)hd * 32768 + e8 * 8;
    for (int cc = 0; cc < nC; cc += 4) {
      uint4 v[4];
#pragma unroll
      for (int u = 0; u < 4; ++u) {
        int c = dir == 0 ? (cc + u) : (nC - 1 - cc - u);
        v[u] = *(const uint4*)(base + (size_t)(seq * nC + c) * (16 * 32768));
      }
#pragma unroll
      for (int u = 0; u < 4; ++u) {
        int c = dir == 0 ? (cc + u) : (nC - 1 - cc - u);
        uint4 o;
        o.x = pack2(R[0], R[1]); o.y = pack2(R[2], R[3]); o.z = pack2(R[4], R[5]); o.w = pack2(R[6], R[7]);
        *(uint4*)(base + (size_t)(seq * nC + c) * (16 * 32768)) = o;
        R[0] = R[0] * dec + bflo(v[u].x); R[1] = R[1] * dec + bfhi(v[u].x);
        R[2] = R[2] * dec + bflo(v[u].y); R[3] = R[3] * dec + bfhi(v[u].y);
        R[4] = R[4] * dec + bflo(v[u].z); R[5] = R[5] * dec + bfhi(v[u].z);
        R[6] = R[6] * dec + bflo(v[u].w); R[7] = R[7] * dec + bfhi(v[u].w);
      }
    }
  }
}

DEV unsigned lds_off(const char* p) { return (unsigned)(unsigned long)((__attribute__((address_space(3))) const char*)p); }
DEV void ro_pv(const char* buf, const bf16x8 (&pf)[4], f32x4 (&oT)[8], int l15, int q) {
#pragma unroll
  for (int d = 0; d < 8; ++d) oT[d] = f32x4{0.f, 0.f, 0.f, 0.f};
  const unsigned base = lds_off(buf) + (unsigned)(l15 * 256 + (q & 1) * 8);
#pragma unroll
  for (int j2 = 0; j2 < 4; ++j2) {
    const unsigned a0 = base + (unsigned)((((j2 * 4 + (q >> 1)) ^ l15) & 15) << 4);
    const unsigned a1 = base + (unsigned)((((j2 * 4 + (q >> 1) + 2) ^ l15) & 15) << 4);
    u32x2 v0[8], v1[8];
    asm volatile(
        "ds_read_b64 %0, %16\n\t"
        "ds_read_b64 %1, %16 offset:4096\n\t"
        "ds_read_b64 %2, %16 offset:8192\n\t"
        "ds_read_b64 %3, %16 offset:12288\n\t"
        "ds_read_b64 %4, %16 offset:16384\n\t"
        "ds_read_b64 %5, %16 offset:20480\n\t"
        "ds_read_b64 %6, %16 offset:24576\n\t"
        "ds_read_b64 %7, %16 offset:28672\n\t"
        "ds_read_b64 %8, %17\n\t"
        "ds_read_b64 %9, %17 offset:4096\n\t"
        "ds_read_b64 %10, %17 offset:8192\n\t"
        "ds_read_b64 %11, %17 offset:12288\n\t"
        "ds_read_b64 %12, %17 offset:16384\n\t"
        "ds_read_b64 %13, %17 offset:20480\n\t"
        "ds_read_b64 %14, %17 offset:24576\n\t"
        "ds_read_b64 %15, %17 offset:28672\n\t"
        "s_waitcnt lgkmcnt(0)"
        : "=&v"(v0[0]), "=&v"(v0[1]), "=&v"(v0[2]), "=&v"(v0[3]), "=&v"(v0[4]), "=&v"(v0[5]), "=&v"(v0[6]), "=&v"(v0[7]),
          "=&v"(v1[0]), "=&v"(v1[1]), "=&v"(v1[2]), "=&v"(v1[3]), "=&v"(v1[4]), "=&v"(v1[5]), "=&v"(v1[6]), "=&v"(v1[7])
        : "v"(a0), "v"(a1)
        : "memory");
#pragma unroll
    for (int dvt = 0; dvt < 8; ++dvt) {
      u32x4 vv = {v0[dvt].x, v0[dvt].y, v1[dvt].x, v1[dvt].y};
      oT[dvt] = MFMA(__builtin_bit_cast(bf16x8, vv), pf[j2], oT[dvt]);
    }
  }
}
DEV void ro_cross(const char* buf, float xi, const bf16x8 (&qf)[4], f32x4 (&oT)[8], int l15, int q) {
  const unsigned base = lds_off(buf) + (unsigned)(l15 * 256);
#pragma unroll
  for (int kd = 0; kd < 4; ++kd) {
    u32x4 raw = __builtin_bit_cast(u32x4, qf[kd]);
    u32x4 o;
    o.x = pack2(bflo(raw.x) * xi, bfhi(raw.x) * xi);
    o.y = pack2(bflo(raw.y) * xi, bfhi(raw.y) * xi);
    o.z = pack2(bflo(raw.z) * xi, bfhi(raw.z) * xi);
    o.w = pack2(bflo(raw.w) * xi, bfhi(raw.w) * xi);
    bf16x8 qs = __builtin_bit_cast(bf16x8, o);
    const unsigned a0 = base + (unsigned)((((kd * 4 + q) ^ l15) & 15) << 4);
    bf16x8 ra[8];
    asm volatile(
        "ds_read_b128 %0, %8\n\t"
        "ds_read_b128 %1, %8 offset:4096\n\t"
        "ds_read_b128 %2, %8 offset:8192\n\t"
        "ds_read_b128 %3, %8 offset:12288\n\t"
        "ds_read_b128 %4, %8 offset:16384\n\t"
        "ds_read_b128 %5, %8 offset:20480\n\t"
        "ds_read_b128 %6, %8 offset:24576\n\t"
        "ds_read_b128 %7, %8 offset:28672\n\t"
        "s_waitcnt lgkmcnt(0)"
        : "=&v"(ra[0]), "=&v"(ra[1]), "=&v"(ra[2]), "=&v"(ra[3]), "=&v"(ra[4]), "=&v"(ra[5]), "=&v"(ra[6]), "=&v"(ra[7])
        : "v"(a0)
        : "memory");
#pragma unroll
    for (int dvt = 0; dvt < 8; ++dvt) oT[dvt] = MFMA(ra[dvt], qs, oT[dvt]);
  }
}
#define RO_WAIT_SYNC() do { asm volatile("s_waitcnt vmcnt(0)" : "+v"(oT[0]), "+v"(oT[1]), "+v"(oT[2]), "+v"(oT[3]), \
    "+v"(oT[4]), "+v"(oT[5]), "+v"(oT[6]), "+v"(oT[7]) : : "memory"); __syncthreads(); } while (0)

__device__ __forceinline__ void ret_out_item(PREF P, int w, const u16* ST, char* smem) {
  const int lane = tid_() & 63, wid = tid_() >> 6, l15 = lane & 15, q = lane >> 4;
  const int rh = w & 1, h = (w >> 1) & 7, n = w >> 4;
  const int tok0 = n * 128;
  const int i = rh * 64 + wid * 16 + l15;
  const float l2f = log_sigmoid(P.decay_logit[h]) * LOG2E;
  const float l2b = log_sigmoid(P.decay_logit[8 + h]) * LOG2E;
  char* X = smem;
  char* Y = smem + 32768;
  const u16* kbase = P.Kr + (size_t)tok0 * 1024 + h * 128;
  const u16* vbase = P.VrT + (size_t)(h * 256) * TS + tok0;
  const u16* rbase = ST + ((size_t)((n * 8 + h) * 2)) * 32768;
#define RO_DMA_K(d) dma_rows256([&](int row) { return kbase + (size_t)row * 1024; }, 128, d)
#define RO_DMA_V(d, hf) dma_rows256([&](int row) { return vbase + (size_t)((hf) * 128 + row) * TS; }, 128, d)
#define RO_DMA_R(d, dir, hf) dma_rows256([&](int row) { return rbase + (size_t)(dir) * 32768 + (size_t)((hf) * 128 + row) * 128; }, 128, d)
  __syncthreads();
  RO_DMA_K(X);
  bf16x8 qf[4];
  {
    const u16* qrow = P.Qr + (size_t)(tok0 + i) * 1024 + h * 128 + q * 8;
#pragma unroll
    for (int kd = 0; kd < 4; ++kd) qf[kd] = *(const bf16x8*)(qrow + kd * 32);
  }
  const float xif = __builtin_amdgcn_exp2f(l2f * (float)(i + 1));
  const float xib = __builtin_amdgcn_exp2f(l2b * (float)(128 - i));
  DMA_WAIT_SYNC();
  RO_DMA_V(Y, 0);
  bf16x8 pf[4];
  {
    f32x4 sT[8];
#pragma unroll
    for (int jt = 0; jt < 8; ++jt) {
      sT[jt] = f32x4{0.f, 0.f, 0.f, 0.f};
#pragma unroll
      for (int kd = 0; kd < 4; ++kd) sT[jt] = MFMA(rd128(X, jt * 16 + l15, kd * 4 + q), qf[kd], sT[jt]);
    }
#pragma unroll
    for (int jt = 0; jt < 8; ++jt)
#pragma unroll
      for (int r = 0; r < 4; ++r) {
        int diff = i - (jt * 16 + q * 4 + r);
        float dcy = diff >= 0 ? __builtin_amdgcn_exp2f(l2f * (float)diff) : __builtin_amdgcn_exp2f(l2b * (float)(-diff));
        sT[jt][r] *= dcy;
      }
#pragma unroll
    for (int j2 = 0; j2 < 4; ++j2) {
      u32x4 pp;
      pp.x = pack2(sT[2 * j2][0], sT[2 * j2][1]);
      pp.y = pack2(sT[2 * j2][2], sT[2 * j2][3]);
      pp.z = pack2(sT[2 * j2 + 1][0], sT[2 * j2 + 1][1]);
      pp.w = pack2(sT[2 * j2 + 1][2], sT[2 * j2 + 1][3]);
      pf[j2] = __builtin_bit_cast(bf16x8, pp);
    }
  }
  f32x4 oT[8];
  u32x2 park[8];
  float ssum = 0.f, ssq = 0.f;
  DMA_WAIT_SYNC();
  RO_DMA_R(X, 0, 0);
  ro_pv(Y, pf, oT, l15, q);
  RO_WAIT_SYNC();
  RO_DMA_R(Y, 1, 0);
  ro_cross(X, xif, qf, oT, l15, q);
  RO_WAIT_SYNC();
  RO_DMA_V(X, 1);
  ro_cross(Y, xib, qf, oT, l15, q);
#pragma unroll
  for (int d = 0; d < 8; ++d) {
#pragma unroll
    for (int r = 0; r < 4; ++r) { float v = oT[d][r]; ssum += v; ssq += v * v; }
    park[d].x = pack2(oT[d][0], oT[d][1]);
    park[d].y = pack2(oT[d][2], oT[d][3]);
  }
  RO_WAIT_SYNC();
  RO_DMA_R(Y, 0, 1);
  ro_pv(X, pf, oT, l15, q);
  RO_WAIT_SYNC();
  RO_DMA_R(X, 1, 1);
  ro_cross(Y, xif, qf, oT, l15, q);
  RO_WAIT_SYNC();
  ro_cross(X, xib, qf, oT, l15, q);
#pragma unroll
  for (int d = 0; d < 8; ++d)
#pragma unroll
    for (int r = 0; r < 4; ++r) { float v = oT[d][r]; ssum += v; ssq += v * v; }
#undef RO_DMA_K
#undef RO_DMA_V
#undef RO_DMA_R
  ssum += __shfl_xor(ssum, 16); ssum += __shfl_xor(ssum, 32);
  ssq += __shfl_xor(ssq, 16); ssq += __shfl_xor(ssq, 32);
  const float mu = ssum * (1.f / 256.f);
  const float var = fmaxf(ssq * (1.f / 256.f) - mu * mu, 0.f);
  const float rs = rsqrtf(var + LN_EPS);
  const int tok = tok0 + i;
  const u16* grow = P.Rg + (size_t)tok * 2048 + h * 256 + q * 4;
  u16* orow = P.ret + (size_t)tok * 2048 + h * 256 + q * 4;
#pragma unroll
  for (int d = 0; d < 8; ++d) {
    {
      u32x2 pvv = park[d];
      uint2 g = *(const uint2*)(grow + d * 16);
      float g0 = bflo(g.x), g1 = bfhi(g.x), g2 = bflo(g.y), g3 = bfhi(g.y);
      uint2 o;
      o.x = pack2((bflo(pvv.x) - mu) * rs * g0 * sigm(g0), (bfhi(pvv.x) - mu) * rs * g1 * sigm(g1));
      o.y = pack2((bflo(pvv.y) - mu) * rs * g2 * sigm(g2), (bfhi(pvv.y) - mu) * rs * g3 * sigm(g3));
      *(uint2*)(orow + d * 16) = o;
    }
    {
      uint2 g = *(const uint2*)(grow + 128 + d * 16);
      float g0 = bflo(g.x), g1 = bfhi(g.x), g2 = bflo(g.y), g3 = bfhi(g.y);
      uint2 o;
      o.x = pack2((oT[d][0] - mu) * rs * g0 * sigm(g0), (oT[d][1] - mu) * rs * g1 * sigm(g1));
      o.y = pack2((oT[d][2] - mu) * rs * g2 * sigm(g2), (oT[d][3] - mu) * rs * g3 * sigm(g3));
      *(uint2*)(orow + 128 + d * 16) = o;
    }
  }
}

__device__ __forceinline__ void phase_att_merge(PREF P, int slab) {
  const int Sshift = slab < 2 ? 12 : 13;
  const int nitems = TS * 8 * 16;
  for (int idx = bid_() * NTHR + tid_(); idx < nitems; idx += gdim_() * NTHR) {
    const int d8 = idx & 15, hs = (idx >> 4) & 7, m = idx >> 7;
    int pg[3];
    float ls[3];
#pragma unroll
    for (int g = 0; g < 3; ++g) {
      pg[g] = posmap(m, Sshift, 2 * g);
      ls[g] = P.lse[((size_t)g * TS + pg[g]) * 8 + hs];
    }
    float mx = fmaxf(ls[0], fmaxf(ls[1], ls[2]));
    float e0 = __expf(ls[0] - mx), e1 = __expf(ls[1] - mx), e2 = __expf(ls[2] - mx);
    float inv = 1.f / (e0 + e1 + e2);
    float wg[3] = {e0 * inv, e1 * inv, e2 * inv};
    float a[8];
#pragma unroll
    for (int e = 0; e < 8; ++e) a[e] = 0.f;
#pragma unroll
    for (int g = 0; g < 3; ++g) {
      uint4 v = *(const uint4*)(P.og + ((size_t)g * TS + pg[g]) * 1024 + hs * 128 + d8 * 8);
      a[0] += wg[g] * bflo(v.x); a[1] += wg[g] * bfhi(v.x);
      a[2] += wg[g] * bflo(v.y); a[3] += wg[g] * bfhi(v.y);
      a[4] += wg[g] * bflo(v.z); a[5] += wg[g] * bfhi(v.z);
      a[6] += wg[g] * bflo(v.w); a[7] += wg[g] * bfhi(v.w);
    }
    uint4 o;
    o.x = pack2(a[0], a[1]); o.y = pack2(a[2], a[3]); o.z = pack2(a[4], a[5]); o.w = pack2(a[6], a[7]);
    *(uint4*)(P.att + (size_t)m * 1024 + hs * 128 + d8 * 8) = o;
  }
}

__device__ __forceinline__ void phase_gemm2(PREF P, char* smem) {
  const int lane = tid_() & 63, wid = tid_() >> 6, wm = wid >> 1, wn = wid & 1, l15 = lane & 15, q = lane >> 4;
  for (int t = bid_(); t < 64 * 16; t += gdim_()) {
    int mt, nt;
    tile_map(t, 2, mt, nt);
    const int m0 = mt * 128, n0 = nt * 128;
    f32x4 acc[4][4];
    gemm_core(P.ret, 2048, P.WretT, 2048, 2048, m0, n0, 13, 0, smem, acc);
#pragma unroll
    for (int i = 0; i < 4; ++i)
#pragma unroll
      for (int j = 0; j < 4; ++j) {
        const int row = m0 + wm * 64 + i * 16 + l15, col = n0 + (j & 1) * 16 + wn * 32 + (j >> 1) * 64 + q * 4;
        const unsigned g = *(const unsigned*)((const u8*)P.GA + (size_t)row * 2048 + col);
        f32x4 v;
        v[0] = (float)(g & 255u) * (1.f / 255.f) * acc[i][j][0]; v[1] = (float)((g >> 8) & 255u) * (1.f / 255.f) * acc[i][j][1];
        v[2] = (float)((g >> 16) & 255u) * (1.f / 255.f) * acc[i][j][2]; v[3] = (float)(g >> 24) * (1.f / 255.f) * acc[i][j][3];
        store_nat(P.merged, 2048, row, col, v);
      }
    gemm_core(P.att, 1024, P.WattT, 1024, 1024, m0, n0, 13, 0, smem, acc);
#pragma unroll
    for (int i = 0; i < 4; ++i)
#pragma unroll
      for (int j = 0; j < 4; ++j) {
        const int row = m0 + wm * 64 + i * 16 + l15, col = n0 + (j & 1) * 16 + wn * 32 + (j >> 1) * 64 + q * 4;
        const unsigned g = *(const unsigned*)((const u8*)P.GB + (size_t)row * 2048 + col);
        uint2 pr = *(const uint2*)(P.merged + (size_t)row * 2048 + col);
        f32x4 v;
        v[0] = bflo(pr.x) + (float)(g & 255u) * (1.f / 255.f) * acc[i][j][0];
        v[1] = bfhi(pr.x) + (float)((g >> 8) & 255u) * (1.f / 255.f) * acc[i][j][1];
        v[2] = bflo(pr.y) + (float)((g >> 16) & 255u) * (1.f / 255.f) * acc[i][j][2];
        v[3] = bfhi(pr.y) + (float)(g >> 24) * (1.f / 255.f) * acc[i][j][3];
        store_nat(P.merged, 2048, row, col, v);
      }
  }
}

__device__ __forceinline__ void phase_gemm3(PREF P, int slab, char* smem) {
  const int lane = tid_() & 63, wid = tid_() >> 6, wm = wid >> 1, wn = wid & 1, l15 = lane & 15, q = lane >> 4;
  for (int t = bid_(); t < 64 * 16; t += gdim_()) {
    int mt, nt;
    tile_map(t, 2, mt, nt);
    const int m0 = mt * 128, n0 = nt * 128;
    f32x4 acc[4][4];
    gemm_core(P.merged, 2048, P.WoutT, 2048, 2048, m0, n0, 13, 0, smem, acc);
#pragma unroll
    for (int i = 0; i < 4; ++i)
#pragma unroll
      for (int j = 0; j < 4; ++j) {
        const int row = m0 + wm * 64 + i * 16 + l15, col = n0 + (j & 1) * 16 + wn * 32 + (j >> 1) * 64 + q * 4;
        store_nat((u16*)P.y, 2048, row, col, acc[i][j]);
      }
  }
}

__device__ __forceinline__ void phase_ln1(PREF P, int slab) {
  const int lane = tid_() & 63, wid = tid_() >> 6;
  const float* xs = x_slab(P, slab);
  for (int t = bid_() * 4 + wid; t < TS; t += gdim_() * 4) {
    const u16* yr = (const u16*)P.y + (size_t)t * 2048;
    const float* xr = xs + (size_t)t * 2048;
    float v[32];
#pragma unroll
    for (int u = 0; u < 4; ++u) {
      u32x4 a = *(const u32x4*)(yr + u * 512 + lane * 8);
      float4 x0 = *(const float4*)(xr + u * 512 + lane * 8), x1 = *(const float4*)(xr + u * 512 + lane * 8 + 4);
      v[u * 8 + 0] = DN_ALPHA * x0.x + bflo(a.x); v[u * 8 + 1] = DN_ALPHA * x0.y + bfhi(a.x);
      v[u * 8 + 2] = DN_ALPHA * x0.z + bflo(a.y); v[u * 8 + 3] = DN_ALPHA * x0.w + bfhi(a.y);
      v[u * 8 + 4] = DN_ALPHA * x1.x + bflo(a.z); v[u * 8 + 5] = DN_ALPHA * x1.y + bfhi(a.z);
      v[u * 8 + 6] = DN_ALPHA * x1.z + bflo(a.w); v[u * 8 + 7] = DN_ALPHA * x1.w + bfhi(a.w);
    }
    float s = 0.f;
#pragma unroll
    for (int e = 0; e < 32; ++e) s += v[e];
    const float mu = wsum(s) * (1.f / 2048.f);
    float vs = 0.f;
#pragma unroll
    for (int e = 0; e < 32; ++e) { float d = v[e] - mu; vs += d * d; }
    const float rs = rsqrtf(wsum(vs) * (1.f / 2048.f) + LN_EPS);
#pragma unroll
    for (int u = 0; u < 4; ++u) {
      const int c = u * 512 + lane * 8;
      float4 g0 = *(const float4*)(P.ln1_g + c), g1 = *(const float4*)(P.ln1_g + c + 4);
      float4 b0 = *(const float4*)(P.ln1_b + c), b1 = *(const float4*)(P.ln1_b + c + 4);
      uint4 o;
      o.x = pack2((v[u * 8 + 0] - mu) * rs * g0.x + b0.x, (v[u * 8 + 1] - mu) * rs * g0.y + b0.y);
      o.y = pack2((v[u * 8 + 2] - mu) * rs * g0.z + b0.z, (v[u * 8 + 3] - mu) * rs * g0.w + b0.w);
      o.z = pack2((v[u * 8 + 4] - mu) * rs * g1.x + b1.x, (v[u * 8 + 5] - mu) * rs * g1.y + b1.y);
      o.w = pack2((v[u * 8 + 6] - mu) * rs * g1.z + b1.z, (v[u * 8 + 7] - mu) * rs * g1.w + b1.w);
      *(uint4*)(P.hb + (size_t)t * 2048 + c) = o;
    }
    float am = 0.f;
#pragma unroll
    for (int u = 0; u < 4; ++u) {
      const int c = u * 512 + lane * 8;
      float4 g0 = *(const float4*)(P.ln1_g + c), g1 = *(const float4*)(P.ln1_g + c + 4);
      float4 b0 = *(const float4*)(P.ln1_b + c), b1 = *(const float4*)(P.ln1_b + c + 4);
      v[u * 8 + 0] = (v[u * 8 + 0] - mu) * rs * g0.x + b0.x; v[u * 8 + 1] = (v[u * 8 + 1] - mu) * rs * g0.y + b0.y;
      v[u * 8 + 2] = (v[u * 8 + 2] - mu) * rs * g0.z + b0.z; v[u * 8 + 3] = (v[u * 8 + 3] - mu) * rs * g0.w + b0.w;
      v[u * 8 + 4] = (v[u * 8 + 4] - mu) * rs * g1.x + b1.x; v[u * 8 + 5] = (v[u * 8 + 5] - mu) * rs * g1.y + b1.y;
      v[u * 8 + 6] = (v[u * 8 + 6] - mu) * rs * g1.z + b1.z; v[u * 8 + 7] = (v[u * 8 + 7] - mu) * rs * g1.w + b1.w;
    }
#pragma unroll
    for (int e = 0; e < 32; ++e) am = fmaxf(am, fabsf(v[e]));
    am = wmax(am);
    const float sc = am > 0.f ? am * (1.f / 127.f) : 1.f;
    const float inv = 1.f / sc;
#pragma unroll
    for (int u = 0; u < 4; ++u) {
      u32x2 o;
      o.x = q4(v[u * 8 + 0], v[u * 8 + 1], v[u * 8 + 2], v[u * 8 + 3], inv, 0);
      o.y = q4(v[u * 8 + 4], v[u * 8 + 5], v[u * 8 + 6], v[u * 8 + 7], inv, 0);
      *(u32x2*)(P.h8 + (size_t)t * 2048 + u * 512 + lane * 8) = o;
    }
    if (lane == 0) P.sh[t] = sc;
  }
}

__device__ __forceinline__ void phase_gemm45(PREF P, char* smem, int which) {
  const int lane = tid_() & 63, wid = tid_() >> 6, wm = wid >> 1, wn = wid & 1, l15 = lane & 15, q = lane >> 4;
  for (int t = bid_(); t < 64 * 16; t += gdim_()) {
    int mt, nt;
    tile_map(t, 2, mt, nt);
    const int m0 = mt * 128, n0 = nt * 128;
    f32x4 acc[4][4];
    if (!which) {
      i32x4 iacc[4][4];
      gemm_core_i8(P.h8, 2048, P.Wq8, 2048, 2048, m0, n0, 13, 0, smem, iacc);
#pragma unroll
      for (int i = 0; i < 4; ++i) {
        const int row = m0 + wm * 64 + i * 16 + l15;
        const float shr = P.sh[row];
#pragma unroll
        for (int j = 0; j < 4; ++j) {
          const int col = n0 + (j & 1) * 16 + wn * 32 + (j >> 1) * 64 + q * 4;
          const float4 swc = *(const float4*)(P.swq + col);
          f32x4 v;
          v[0] = (float)iacc[i][j][0] * shr * swc.x; v[1] = (float)iacc[i][j][1] * shr * swc.y;
          v[2] = (float)iacc[i][j][2] * shr * swc.z; v[3] = (float)iacc[i][j][3] * shr * swc.w;
          store_nat(P.qb, 2048, row, col, v);
        }
      }
    } else {
      unsigned part[4][4][2];
      {
        i32x4 iacc[4][4];
        gemm_core_i8(P.h8, 2048, P.Wpg8, 2048, 2048, m0, n0, 13, 0, smem, iacc);
#pragma unroll
        for (int i = 0; i < 4; ++i) {
          const int row = m0 + wm * 64 + i * 16 + l15;
          const float shr = P.sh[row];
#pragma unroll
          for (int j = 0; j < 4; ++j) {
            const int col = n0 + (j & 1) * 16 + wn * 32 + (j >> 1) * 64 + q * 4;
            const float4 swc = *(const float4*)(P.swpg + col);
            part[i][j][0] = pack2(sigm((float)iacc[i][j][0] * shr * swc.x), sigm((float)iacc[i][j][1] * shr * swc.y));
            part[i][j][1] = pack2(sigm((float)iacc[i][j][2] * shr * swc.z), sigm((float)iacc[i][j][3] * shr * swc.w));
          }
        }
      }
      gemm_core(P.pb, 256, P.WpeT, 256, 256, m0, n0, 13, 0, smem, acc);
#pragma unroll
      for (int i = 0; i < 4; ++i)
#pragma unroll
        for (int j = 0; j < 4; ++j) {
          const int row = m0 + wm * 64 + i * 16 + l15, col = n0 + (j & 1) * 16 + wn * 32 + (j >> 1) * 64 + q * 4;
          f32x4 v;
          v[0] = bflo(part[i][j][0]) * acc[i][j][0]; v[1] = bfhi(part[i][j][0]) * acc[i][j][1];
          v[2] = bflo(part[i][j][1]) * acc[i][j][2]; v[3] = bfhi(part[i][j][1]) * acc[i][j][3];
          store_nat(P.peb, 2048, row, col, v);
        }
    }
  }
}

DEV void ce_insert(float (&top)[16], float x) {
#pragma unroll
  for (int p = 0; p < 16; ++p) {
    float hi = fmaxf(top[p], x), lo = fminf(top[p], x);
    top[p] = hi; x = lo;
  }
}

__device__ __forceinline__ void peer_topk_item(PREF P, int w, char* smem) {
  float* Ls = (float*)smem;
  float* Ll = (float*)(smem + 2 * 64 * 129 * 4);
  const int tid = tid_(), lane = tid & 63, wid = tid >> 6, l15 = lane & 15, q = lane >> 4;
  const int tb = w >> 3, h = w & 7, t0 = tb * 64;
  __syncthreads();
  {
    const int c = wid >> 1, th = wid & 1;
    f32x4 acc[8][2];
#pragma unroll
    for (int a = 0; a < 8; ++a) { acc[a][0] = f32x4{0.f, 0.f, 0.f, 0.f}; acc[a][1] = f32x4{0.f, 0.f, 0.f, 0.f}; }
#pragma unroll
    for (int kd = 0; kd < 4; ++kd) {
      bf16x8 qf[2];
#pragma unroll
      for (int tt = 0; tt < 2; ++tt)
        qf[tt] = *(const bf16x8*)(P.qb + (size_t)(t0 + th * 32 + tt * 16 + l15) * 2048 + h * 256 + c * 128 + kd * 32 + q * 8);
#pragma unroll
      for (int kt = 0; kt < 8; ++kt) {
        bf16x8 kf = *(const bf16x8*)(P.keysb + (size_t)((h * 2 + c) * 128 + kt * 16 + l15) * 128 + kd * 32 + q * 8);
        acc[kt][0] = MFMA(kf, qf[0], acc[kt][0]);
        acc[kt][1] = MFMA(kf, qf[1], acc[kt][1]);
      }
    }
#pragma unroll
    for (int kt = 0; kt < 8; ++kt)
#pragma unroll
      for (int tt = 0; tt < 2; ++tt)
#pragma unroll
        for (int r = 0; r < 4; ++r) Ls[(c * 64 + th * 32 + tt * 16 + l15) * 129 + kt * 16 + q * 4 + r] = acc[kt][tt][r];
  }
  __syncthreads();
  {
    const int row = tid & 127, half = tid >> 7;
    float top[16];
#pragma unroll
    for (int k = 0; k < 16; ++k) top[k] = -3.0e38f;
    const float* src = Ls + row * 129 + half * 64;
#pragma unroll 4
    for (int k = 0; k < 64; ++k) {
      float x = __uint_as_float((__float_as_uint(src[k]) & ~127u) | (unsigned)(half * 64 + k));
      ce_insert(top, x);
    }
    if (half == 1) {
#pragma unroll
      for (int k = 0; k < 16; ++k) Ll[row * 17 + k] = top[k];
    }
    __syncthreads();
    if (half == 0) {
#pragma unroll
      for (int k = 0; k < 16; ++k) ce_insert(top, Ll[row * 17 + k]);
    }
    __syncthreads();
    if (half == 0) {
#pragma unroll
      for (int k = 0; k < 16; ++k) Ll[row * 17 + k] = top[k];
    }
    __syncthreads();
  }
  if (tid < 64) {
    const int t = tid;
    float a[16], b[16];
#pragma unroll
    for (int k = 0; k < 16; ++k) {
      a[k] = __uint_as_float(__float_as_uint(Ll[t * 17 + k]) & ~127u);
      b[k] = __uint_as_float(__float_as_uint(Ll[(64 + t) * 17 + k]) & ~127u);
    }
    float top[16];
#pragma unroll
    for (int k = 0; k < 16; ++k) top[k] = -3.0e38f;
#pragma unroll
    for (int i = 0; i < 16; ++i)
#pragma unroll
      for (int j = 0; j < 16; ++j)
        if ((i + 1) * (j + 1) <= 16) {
          float s = a[i] + b[j];
          s = __uint_as_float((__float_as_uint(s) & ~255u) | (unsigned)(i * 16 + j));
          ce_insert(top, s);
        }
    const float best0 = __uint_as_float(__float_as_uint(top[0]) & ~255u);
    float ev[16], sum = 0.f;
#pragma unroll
    for (int k = 0; k < 16; ++k) {
      float bk = __uint_as_float(__float_as_uint(top[k]) & ~255u);
      ev[k] = __expf(bk - best0);
      sum += ev[k];
    }
    const float inv = 1.f / sum;
#pragma unroll
    for (int k = 0; k < 16; ++k) {
      unsigned code = __float_as_uint(top[k]) & 255u;
      int ia = __float_as_uint(Ll[t * 17 + (code >> 4)]) & 127u;
      int ib = __float_as_uint(Ll[(64 + t) * 17 + (code & 15u)]) & 127u;
      P.eidx[(size_t)(t0 + t) * 128 + h * 16 + k] = ia * 128 + ib;
      P.gw[(size_t)(t0 + t) * 128 + h * 16 + k] = ev[k] * inv;
    }
  }
}

DEV float gelu_exact(float x) { return 0.5f * x * (1.f + erff(x * 0.70710678118654752f)); }
DEV void axpy_ub(float* acc, float c, unsigned w) {
  acc[0] += c * (float)(w & 0xffu); acc[1] += c * (float)((w >> 8) & 0xffu);
  acc[2] += c * (float)((w >> 16) & 0xffu); acc[3] += c * (float)(w >> 24);
}
DEV void ld16bf(const u16* p, float* o) {
  u32x4 a = *(const u32x4*)p, b = *(const u32x4*)(p + 8);
  o[0] = bflo(a.x); o[1] = bfhi(a.x); o[2] = bflo(a.y); o[3] = bfhi(a.y);
  o[4] = bflo(a.z); o[5] = bfhi(a.z); o[6] = bflo(a.w); o[7] = bfhi(a.w);
  o[8] = bflo(b.x); o[9] = bfhi(b.x); o[10] = bflo(b.y); o[11] = bfhi(b.y);
  o[12] = bflo(b.z); o[13] = bfhi(b.z); o[14] = bflo(b.w); o[15] = bfhi(b.w);
}

__device__ __forceinline__ void phase_peer_gather(PREF P, int slab, int tbeg, int tend) {
  const int lane = tid_() & 63, wid = tid_() >> 6;
  float* outs = P.out + (size_t)slab * TS * DM;
  typedef const __attribute__((address_space(1))) unsigned char* gbytes_t;
  gbytes_t U8 = (gbytes_t)P.Ub;
  gbytes_t V8 = (gbytes_t)P.Vb;
  for (int t = tbeg + bid_() * 4 + wid; t < tend; t += gdim_() * 4) {
    const u16* hrow = P.hb + (size_t)t * 2048 + lane * 16;
    int xq[8];
    float sh;
    {
      float hv[32];
      ld16bf(hrow, hv);
      ld16bf(hrow + 1024, hv + 16);
      float am = 0.f;
#pragma unroll
      for (int e = 0; e < 32; ++e) am = fmaxf(am, fabsf(hv[e]));
      am = wmax(am);
      sh = am > 0.f ? am * (1.f / 127.f) : 1.f;
      const float inv = 1.f / sh;
#pragma unroll
      for (int w = 0; w < 8; ++w) xq[w] = (int)q4(hv[w * 4], hv[w * 4 + 1], hv[w * 4 + 2], hv[w * 4 + 3], inv, 0);
    }
    float acc[32];
#pragma unroll
    for (int e = 0; e < 32; ++e) acc[e] = 0.f;
    float csum = 0.f;
#pragma unroll 1
    for (int half = 0; half < 2; ++half) {
      const int ev = P.eidx[(size_t)t * 128 + half * 64 + lane];
      const int gv = __float_as_int(P.gw[(size_t)t * 128 + half * 64 + lane]);
      const int suv = __float_as_int(P.su[ev]);
      const int svv = __float_as_int(P.sv[ev]);
#pragma unroll 1
      for (int e = 0; e < 64; e += 4) {
        u32x4 ua[4][2], va[4][2];
        float cg[4], csu[4], csv[4];
#pragma unroll
        for (int k = 0; k < 4; ++k) {
          const int ix = __builtin_amdgcn_readlane(ev, e + k);
          cg[k] = __int_as_float(__builtin_amdgcn_readlane(gv, e + k));
          csu[k] = __int_as_float(__builtin_amdgcn_readlane(suv, e + k));
          csv[k] = __int_as_float(__builtin_amdgcn_readlane(svv, e + k));
          typedef const __attribute__((address_space(1))) u32x4* gvec_t;
          gbytes_t up = U8 + (size_t)ix * 2048 + lane * 16;
          gbytes_t vp = V8 + (size_t)ix * 2048 + lane * 16;
          ua[k][0] = *(gvec_t)up; ua[k][1] = *(gvec_t)(up + 1024);
          va[k][0] = *(gvec_t)vp; va[k][1] = *(gvec_t)(vp + 1024);
        }
        int id[4];
#pragma unroll
        for (int k = 0; k < 4; ++k) {
          int d = 0;
          d = __builtin_amdgcn_sdot4((int)ua[k][0].x, xq[0], d, false); d = __builtin_amdgcn_sdot4((int)ua[k][0].y, xq[1], d, false);
          d = __builtin_amdgcn_sdot4((int)ua[k][0].z, xq[2], d, false); d = __builtin_amdgcn_sdot4((int)ua[k][0].w, xq[3], d, false);
          d = __builtin_amdgcn_sdot4((int)ua[k][1].x, xq[4], d, false); d = __builtin_amdgcn_sdot4((int)ua[k][1].y, xq[5], d, false);
          d = __builtin_amdgcn_sdot4((int)ua[k][1].z, xq[6], d, false); d = __builtin_amdgcn_sdot4((int)ua[k][1].w, xq[7], d, false);
          id[k] = d;
        }
#pragma unroll
        for (int k = 0; k < 4; ++k) id[k] = wsum_i(id[k]);
#pragma unroll
        for (int k = 0; k < 4; ++k) {
          const float d = (float)id[k] * csu[k] * sh;
          const float c = cg[k] * gelu_exact(d) * csv[k];
          csum += c;
          axpy_ub(acc + 0, c, va[k][0].x);  axpy_ub(acc + 4, c, va[k][0].y);
          axpy_ub(acc + 8, c, va[k][0].z);  axpy_ub(acc + 12, c, va[k][0].w);
          axpy_ub(acc + 16, c, va[k][1].x); axpy_ub(acc + 20, c, va[k][1].y);
          axpy_ub(acc + 24, c, va[k][1].z); axpy_ub(acc + 28, c, va[k][1].w);
        }
      }
    }
    {
      const float corr = 128.f * csum;
      float hv[16], pv[16];
#pragma unroll
      for (int hf = 0; hf < 2; ++hf) {
        ld16bf(hrow + hf * 1024, hv);
        ld16bf(P.peb + (size_t)t * 2048 + lane * 16 + hf * 1024, pv);
#pragma unroll
        for (int e = 0; e < 16; ++e) acc[hf * 16 + e] = acc[hf * 16 + e] - corr + DN_ALPHA * hv[e] + pv[e];
      }
    }
    float s = 0.f;
#pragma unroll
    for (int e = 0; e < 32; ++e) s += acc[e];
    const float mu = wsum(s) * (1.f / 2048.f);
    float vs = 0.f;
#pragma unroll
    for (int e = 0; e < 32; ++e) { float d = acc[e] - mu; vs += d * d; }
    const float rs = rsqrtf(wsum(vs) * (1.f / 2048.f) + LN_EPS);
    float* orow = outs + (size_t)t * 2048;
#pragma unroll
    for (int hf = 0; hf < 2; ++hf)
#pragma unroll
      for (int c4 = 0; c4 < 4; ++c4) {
        const int c = hf * 1024 + lane * 16 + c4 * 4;
        float4 g = *(const float4*)(P.ln2_g + c), b = *(const float4*)(P.ln2_b + c);
        float4 o;
        o.x = (acc[hf * 16 + c4 * 4 + 0] - mu) * rs * g.x + b.x;
        o.y = (acc[hf * 16 + c4 * 4 + 1] - mu) * rs * g.y + b.y;
        o.z = (acc[hf * 16 + c4 * 4 + 2] - mu) * rs * g.z + b.z;
        o.w = (acc[hf * 16 + c4 * 4 + 3] - mu) * rs * g.w + b.w;
        *(float4*)(orow + c) = o;
      }
  }
}

__device__ void build_bias_table(PREF P) {
  const int gtid = bid_() * NTHR + tid_();
  if (gtid < 24 * 129) {
    const int o = gtid % 129, gh = gtid / 129, gi = gh >> 3;
    const int rel = (o - 64) << (2 * gi);
    int ret = rel > 0 ? 16 : 0;
    int n = rel < 0 ? -rel : rel;
    int bucket;
    if (n < 8) bucket = n;
    else {
      int large = 8 + (int)(logf((float)n / 8.f) / 4.852030263919617f * 8.f);
      bucket = large < 15 ? large : 15;
    }
    P.biasT[gtid] = P.rel_bias[(ret + bucket) * 24 + gh];
  }
}

#define XB_TMO      128
#define XB_XCNT(j)  (256  + 64 * (j))
#define XB_XSUB(j)  (1280 + 64 * (j))
#define XB_XGEN(j)  (2304 + 64 * (j))
#define XB_TOP      3328
#define XB_TOPGEN   3392
#define XCD_BAR_WORDS 3456
#define CU_CENSUS_BASE 3584
#define BAR_TOTAL_WORDS (3584 + 4096)
#define XB_SPIN_CAP (1u << 20)
#define LAS __attribute__((address_space(3)))
DEV unsigned xb_ld(unsigned* p) { return __hip_atomic_load(p, __ATOMIC_RELAXED, __HIP_MEMORY_SCOPE_AGENT); }
DEV unsigned xb_add(unsigned* p, unsigned v) { return __hip_atomic_fetch_add(p, v, __ATOMIC_RELAXED, __HIP_MEMORY_SCOPE_AGENT); }
DEV unsigned xb_xcc_id() { return (unsigned)__builtin_amdgcn_s_getreg((3 << 11) | 20) & 0xFu; }
#define XB_SPIN(cond, bar) do { unsigned _sp = 0; while (cond) { __builtin_amdgcn_s_sleep(1); \
    if ((++_sp & 255u) == 0u) { if (xb_ld(&(bar)[XB_TMO])) break; if (_sp > XB_SPIN_CAP) { atomicAdd(&(bar)[XB_TMO], 1u); break; } } } } while (0)
struct XcdBarrier { unsigned* bar; unsigned x; volatile LAS unsigned* st; };
DEV XcdBarrier xcd_barrier_post(unsigned* bar, volatile LAS unsigned* st) {
  XcdBarrier b; b.bar = bar; b.x = xb_xcc_id(); b.st = st;
  if (threadIdx.x == 0) (void)xb_add(&bar[XB_XCNT(b.x)], 1u);
  return b;
}
DEV void xcd_barrier_complete(unsigned* bar, unsigned x, unsigned& nloc, unsigned& nx) {
  const unsigned G = gridDim.x * gridDim.y * gridDim.z;
  unsigned sum, cnt, mine, sp = 0u;
  for (;;) {
    sum = 0u; cnt = 0u; mine = 0u;
#pragma unroll
    for (unsigned j = 0; j < 16; ++j) { const unsigned c = xb_ld(&bar[XB_XCNT(j)]); sum += c; cnt += (c > 0u) ? 1u : 0u; mine = (j == x) ? c : mine; }
    if (sum == G) break;
    __builtin_amdgcn_s_sleep(1);
    if ((++sp & 255u) == 0u) { if (xb_ld(&bar[XB_TMO])) break; if (sp > XB_SPIN_CAP) { atomicAdd(&bar[XB_TMO], 1u); break; } }
  }
  nloc = mine > 0u ? mine : 1u; nx = cnt > 0u ? cnt : 1u;
}
DEV void xcd_barrier(const XcdBarrier& b) {
  asm volatile("s_waitcnt vmcnt(0)" ::: "memory");
  __syncthreads();
  if (threadIdx.x == 0) {
    unsigned* bar = b.bar;
    __builtin_amdgcn_s_waitcnt(0);
    unsigned nloc = b.st[0], nx = b.st[1];
    if (nloc == 0u) { xcd_barrier_complete(bar, b.x, nloc, nx); b.st[0] = nloc; b.st[1] = nx; }
    const unsigned old = xb_add(&bar[XB_XSUB(b.x)], 1u);
    const unsigned gen = old / nloc;
    if (old + 1u == (gen + 1u) * nloc) {
      __builtin_amdgcn_fence(__ATOMIC_RELEASE, "agent");
      asm volatile("s_waitcnt vmcnt(0)" ::: "memory");
      const unsigned og = xb_add(&bar[XB_TOP], 1u);
      const unsigned tg = og / nx;
      if (og + 1u == (tg + 1u) * nx) xb_add(&bar[XB_TOPGEN], 1u);
      else XB_SPIN(xb_ld(&bar[XB_TOPGEN]) == tg, bar);
      __builtin_amdgcn_fence(__ATOMIC_ACQUIRE, "agent");
      xb_add(&bar[XB_XGEN(b.x)], 1u);
      asm volatile("s_waitcnt vmcnt(0)" ::: "memory");
    } else {
      XB_SPIN(xb_ld(&bar[XB_XGEN(b.x)]) == gen, bar);
      __builtin_amdgcn_fence(__ATOMIC_ACQUIRE, "agent");
      asm volatile("s_waitcnt vmcnt(0)" ::: "memory");
    }
  }
  __syncthreads();
}

#ifndef REPA
#define REPA 1
#endif
#ifndef REPB
#define REPB 1
#endif
#ifndef REPD
#define REPD 1
#endif
#ifndef REPE
#define REPE 1
#endif
#ifndef REPI
#define REPI 1
#endif
#ifndef REPJ
#define REPJ 1
#endif
#ifndef REPS
#define REPS 1
#endif
__global__ void __launch_bounds__(NTHR, 2) fwd_megakernel(Params Pk) {
  __shared__ __attribute__((aligned(16))) char smem[SMEM_BYTES];
  __shared__ Params sP;
  cg::grid_group grid = cg::this_grid();
  {
    const unsigned* srcw = (const unsigned*)&Pk;
    unsigned* dstw = (unsigned*)&sP;
    for (int i = tid_(); i < (int)(sizeof(Params) / 4); i += NTHR) dstw[i] = srcw[i];
  }
  __shared__ uint4 xb_words;
  __shared__ unsigned cu_slot_s;
  if (threadIdx.x == 0) xb_words = make_uint4(0u, 0u, 0u, 0u);
  __syncthreads();
  LParams* lp = (LParams*)&sP;
#define P (*launderP(lp))
  const XcdBarrier xb = xcd_barrier_post(Pk.bar, (volatile LAS unsigned*)&xb_words);
  if (threadIdx.x == 0) {
    const unsigned hwid = (unsigned)__builtin_amdgcn_s_getreg((31 << 11) | 4);
    const unsigned key = (xb.x & 15u) * 256u + ((hwid >> 8) & 127u);
    cu_slot_s = xb_add(&Pk.bar[CU_CENSUS_BASE + key], 1u);
  }
  __syncthreads();
  const int cu_slot = (int)(blockIdx.x & 1u);
#define GSYNC() xcd_barrier(xb)

  transpose_convert(P.w_in, 2048, 19456, P.WinTtmp, smem);
  transpose_convert(P.w_ret_o, 2048, 2048, P.WretT, smem);
  transpose_convert(P.w_att_o, 1024, 2048, P.WattT, smem);
  transpose_convert(P.w_out, 2048, 2048, P.WoutT, smem);
  transpose_convert(P.peer_wq, 2048, 2048, P.WqTtmp, smem);
  transpose_convert(P.w_pg, 2048, 2048, P.WpgTtmp, smem);
  transpose_convert(P.w_pe, 256, 2048, P.WpeT, smem);
  convert_bf16(P.peer_keys, P.keysb, 262144 / 8);
  quant_rows_f32(P.peer_u, (unsigned char*)P.Ub, P.su, 16384, 0);
  quant_rows_f32(P.peer_v, (unsigned char*)P.Vb, P.sv, 16384, 128);
  quant_rows_f32(x_slab(P, 0), P.xq8, P.sx, TS, 0);
  build_bias_table(P);
  grid.sync();
  quant_rows_bf16(P.WinTtmp, P.Win8, P.sw, 19456);
  quant_rows_bf16(P.WpgTtmp, P.Wpg8, P.swpg, 2048);
  quant_rows_bf16(P.WqTtmp, P.Wq8, P.swq, 2048);
  GSYNC();

#pragma unroll 1
  for (int slab = -1; slab < 4; ++slab) {
    if (slab >= 0) {
      const int Sshift = slab < 2 ? 12 : 13;
      u16* ST = (u16*)(P.out + (size_t)slab * TS * DM);
#pragma unroll 1
      for (int part = 0; part < 2; ++part) {
        if (part == cu_slot) {
          for (int w = bid_(); w < 1024 + 3072; w += gdim_()) {
            if (w < 1024) ret_kv_item(P, w, ST, smem);
            else attn_item(P, w - 1024, Sshift, smem);
          }
        } else if (slab >= 1) {
          phase_peer_gather(P, slab - 1, JSPLIT, TS);
        }
      }
      GSYNC();
      phase_scan(P, slab, ST);
      if (slab + 1 < 4) quant_rows_f32(x_slab(P, slab + 1), P.xq8, P.sx, TS, 0);
      convert_bf16(p_slab(P, slab), P.pb, (size_t)TS * 256 / 8);
      phase_att_merge(P, slab);
      GSYNC();
      for (int w = bid_(); w < 1024; w += gdim_()) ret_out_item(P, w, ST, smem);
      GSYNC();
      phase_gemm2(P, smem);
      GSYNC();
      phase_gemm3(P, slab, smem);
      GSYNC();
      phase_ln1(P, slab);
      GSYNC();
      phase_gemm45(P, smem, 0);
      GSYNC();
#pragma unroll 1
      for (int part = 0; part < 2; ++part) {
        if (part == cu_slot) phase_gemm45(P, smem, 1);
        else for (int w = bid_(); w < 1024; w += gdim_()) peer_topk_item(P, w, smem);
      }
      GSYNC();
    }
#pragma unroll 1
    for (int part = 0; part < 2; ++part) {
      if (part == cu_slot) { if (slab + 1 < 4) phase_gemm1(P, slab + 1, smem); }
      else { if (slab >= 0) phase_peer_gather(P, slab, 0, slab + 1 < 4 ? JSPLIT : TS); }
    }
    GSYNC();
  }
}

#undef P
#undef GSYNC
extern "C" void kernel_launch(void* const* d_in, const int* in_sizes, int n_in, void* d_out, int out_size, void* d_ws,
                              size_t ws_size, hipStream_t stream) {
  Params P;
  std::memset((void*)&P, 0, sizeof(P));
  P.x_prompt = (const float*)d_in[0];  P.x_sample = (const float*)d_in[1];
  P.p_prompt = (const float*)d_in[2];  P.p_sample = (const float*)d_in[3];
  P.w_in = (const float*)d_in[4];      P.decay_logit = (const float*)d_in[5];
  P.w_ret_o = (const float*)d_in[6];   P.w_att_o = (const float*)d_in[7];
  P.w_out = (const float*)d_in[8];     P.rel_bias = (const float*)d_in[9];
  P.ln1_g = (const float*)d_in[10];    P.ln1_b = (const float*)d_in[11];
  P.peer_wq = (const float*)d_in[12];  P.peer_keys = (const float*)d_in[13];
  P.peer_u = (const float*)d_in[14];   P.peer_v = (const float*)d_in[15];
  P.w_pe = (const float*)d_in[16];     P.w_pg = (const float*)d_in[17];
  P.ln2_g = (const float*)d_in[18];    P.ln2_b = (const float*)d_in[19];
  P.out = (float*)d_out;

  char* base = (char*)d_ws;
  size_t off = 0;
  auto take = [&](size_t bytes) { char* p = base + off; off += (bytes + 255) & ~(size_t)255; return p; };
  P.Win8 = (u8*)take((size_t)19456 * 2048);
  P.sw = (float*)take((size_t)19456 * 4);
  P.WretT = (u16*)take((size_t)2048 * 2048 * 2);
  P.WattT = (u16*)take((size_t)2048 * 1024 * 2);
  P.WoutT = (u16*)take((size_t)2048 * 2048 * 2);
  P.Wq8 = (u8*)take((size_t)2048 * 2048);
  P.swq = (float*)take((size_t)2048 * 4);
  P.Wpg8 = (u8*)take((size_t)2048 * 2048);
  P.swpg = (float*)take((size_t)2048 * 4);
  P.WpeT = (u16*)take((size_t)2048 * 256 * 2);
  P.keysb = (u16*)take((size_t)262144 * 2);
  P.Ub = (u16*)take((size_t)16384 * 2048);
  P.Vb = (u16*)take((size_t)16384 * 2048);
  P.su = (float*)take((size_t)16384 * 4);
  P.sv = (float*)take((size_t)16384 * 4);
  P.xq8 = (u8*)take((size_t)TS * 2048);
  P.sx = (float*)take((size_t)TS * 4);
  P.h8 = (u8*)take((size_t)TS * 2048);
  P.sh = (float*)take((size_t)TS * 4);
  P.pb = (u16*)take((size_t)TS * 256 * 2);
  P.Qr = (u16*)take((size_t)TS * 1024 * 2);
  P.Kr = (u16*)take((size_t)TS * 1024 * 2);
  P.KrT = (u16*)take((size_t)TS * 1024 * 2);
  P.VrT = (u16*)take((size_t)TS * 2048 * 2);
  P.Rg = (u16*)take((size_t)TS * 2048 * 2);
  P.AQ = (u16*)take((size_t)TS * 3072 * 2);
  P.AK = (u16*)take((size_t)TS * 3072 * 2);
  P.AVT = (u16*)take((size_t)TS * 3072 * 2);
  P.GA = (u16*)take((size_t)TS * 2048 * 2);
  P.GB = (u16*)take((size_t)TS * 2048 * 2);
  P.og = (u16*)take((size_t)3 * TS * 1024 * 2);
  P.lse = (float*)take((size_t)3 * TS * 8 * 4);
  P.ret = (u16*)take((size_t)TS * 2048 * 2);
  P.att = (u16*)take((size_t)TS * 1024 * 2);
  P.eidx = (int*)take((size_t)TS * 128 * 4);
  P.gw = (float*)take((size_t)TS * 128 * 4);
  P.biasT = (float*)take((size_t)24 * 129 * 4);
  P.bar = (unsigned*)take((size_t)BAR_TOTAL_WORDS * 4);
  P.WinTtmp = P.Qr;
  P.WpgTtmp = P.Rg;
  P.WqTtmp = P.Rg + (size_t)2048 * 2048;
  P.merged = P.og;
  P.y = (float*)P.Qr;
  P.hb = (u16*)take((size_t)TS * 2048 * 2);
  P.qb = P.AQ;
  P.peb = (u16*)take((size_t)TS * 2048 * 2);
  if (off > ws_size) fprintf(stderr, "workspace too small: need %zu have %zu\n", off, ws_size);
  for (int d = 0; d < 64; ++d) P.ropec[d] = (float)(pow(10000.0, -(double)d / 63.0) / (2.0 * M_PI));

  static int grid_blocks = 0;
  if (!grid_blocks) {
    int dev = 0, cus = 0, per_cu = 0;
    (void)hipGetDevice(&dev);
    (void)hipDeviceGetAttribute(&cus, hipDeviceAttributeMultiprocessorCount, dev);
    (void)hipOccupancyMaxActiveBlocksPerMultiprocessor(&per_cu, fwd_megakernel, NTHR, 0);
    if (per_cu > 2) per_cu = 2;
    if (per_cu < 1) per_cu = 1;
    grid_blocks = cus * per_cu;
  }
  (void)hipMemsetAsync(P.bar, 0, (size_t)BAR_TOTAL_WORDS * 4, stream);
  void* args[] = {&P};
  hipError_t e = hipLaunchCooperativeKernel((void*)fwd_megakernel, dim3(grid_blocks), dim3(NTHR), args, 0, stream);
  if (e != hipSuccess) fprintf(stderr, "cooperative launch failed: %s (grid %d)\n", hipGetErrorString(e), grid_blocks);
}
```

```cpp
#include <hip/hip_runtime.h>
#include <hip/hip_cooperative_groups.h>
#include <cstdio>
#include <cmath>
#include <cstring>
namespace cg = cooperative_groups;

typedef unsigned short u16;
typedef short bf16x8 __attribute__((ext_vector_type(8)));
typedef float f32x4 __attribute__((ext_vector_type(4)));
typedef __bf16 bf16x2_t __attribute__((ext_vector_type(2)));
typedef float f32x2_t __attribute__((ext_vector_type(2)));
typedef unsigned u32x4 __attribute__((ext_vector_type(4)));
typedef unsigned u32x2 __attribute__((ext_vector_type(2)));
typedef int i32x4 __attribute__((ext_vector_type(4)));
typedef unsigned char u8;

#define DEV __device__ __forceinline__
#define MFMA(a, b, c) __builtin_amdgcn_mfma_f32_16x16x32_bf16((a), (b), (c), 0, 0, 0)

constexpr int TS = 8192;
constexpr int DM = 2048;
constexpr int NTHR = 256;
constexpr int JSPLIT = 6144;
constexpr int SMEM_BYTES = 74752;
constexpr float DN_ALPHA = 1.189207115002721f;
constexpr float LN_EPS = 1e-5f;
constexpr float QK_SCALE = 0.08838834764831845f;
constexpr float LOG2E = 1.4426950408889634f;

struct Params {
  const float *x_prompt, *x_sample, *p_prompt, *p_sample, *w_in, *decay_logit, *w_ret_o, *w_att_o, *w_out, *rel_bias,
      *ln1_g, *ln1_b, *peer_wq, *peer_keys, *peer_u, *peer_v, *w_pe, *w_pg, *ln2_g, *ln2_b;
  float* out;
  u16 *WretT, *WattT, *WoutT, *WpeT, *keysb, *Ub, *Vb;
  u16 *pb, *Qr, *Kr, *KrT, *VrT, *Rg, *AQ, *AK, *AVT, *GA, *GB, *og, *ret, *att, *merged, *hb, *qb, *peb;
  float *lse, *y, *gw, *biasT, *su, *sv, *sx, *sw, *swpg, *swq, *sh;
  u8 *xq8, *Win8, *Wpg8, *Wq8, *h8;
  u16 *WinTtmp, *WpgTtmp, *WqTtmp;
  int* eidx;
  unsigned* bar;
  float ropec[64];
};

typedef const __attribute__((address_space(3))) Params LParams;
#define PREF LParams&
DEV LParams* launderP(LParams* p) { asm volatile("" : "+v"(p)); return p; }
DEV int tid_() { int t = threadIdx.x; asm volatile("" : "+v"(t)); return t; }
DEV int bid_() { int t = blockIdx.x; asm volatile("" : "+s"(t)); return t; }
DEV int gdim_() { int t = gridDim.x; asm volatile("" : "+s"(t)); return t; }
DEV unsigned pack2(float a, float b) {
  f32x2_t v = {a, b};
  bf16x2_t r = __builtin_convertvector(v, bf16x2_t);
  return __builtin_bit_cast(unsigned, r);
}
DEV float bflo(unsigned u) { return __uint_as_float(u << 16); }
DEV float bfhi(unsigned u) { return __uint_as_float(u & 0xffff0000u); }
DEV u16 f2bf(float a) { return (u16)(pack2(a, 0.f) & 0xffffu); }
DEV float sigm(float x) { return 1.f / (1.f + __expf(-x)); }
DEV float wsum(float v) {
  v += __shfl_xor(v, 32); v += __shfl_xor(v, 16); v += __shfl_xor(v, 8);
  v += __shfl_xor(v, 4);  v += __shfl_xor(v, 2);  v += __shfl_xor(v, 1);
  return v;
}
DEV float log_sigmoid(float x) { return -log1pf(expf(-x)); }

DEV int rowmap(int p, int Sshift, int dl) {
  int seq = p >> Sshift, pp = p & ((1 << Sshift) - 1);
  int Lshift = Sshift - dl;
  int r = pp >> Lshift, l = pp & ((1 << Lshift) - 1);
  return (seq << Sshift) + (l << dl) + r;
}
DEV int posmap(int m, int Sshift, int dl) {
  int seq = m >> Sshift, s = m & ((1 << Sshift) - 1);
  int Lshift = Sshift - dl;
  return (seq << Sshift) + ((s & ((1 << dl) - 1)) << Lshift) + (s >> dl);
}

DEV const float* x_slab(PREF P, int slab) {
  return slab < 2 ? P.x_prompt + (size_t)slab * TS * DM : P.x_sample + (size_t)(slab - 2) * TS * DM;
}
DEV const float* p_slab(PREF P, int slab) {
  return slab < 2 ? P.p_prompt + (size_t)slab * TS * 256 : P.p_sample + (size_t)(slab - 2) * TS * 256;
}

__device__ void convert_bf16(const float* __restrict__ src, u16* __restrict__ dst, size_t n8) {
  for (size_t i = (size_t)bid_() * NTHR + tid_(); i < n8; i += (size_t)gdim_() * NTHR) {
    float4 a = ((const float4*)src)[2 * i], b = ((const float4*)src)[2 * i + 1];
    uint4 o;
    o.x = pack2(a.x, a.y); o.y = pack2(a.z, a.w); o.z = pack2(b.x, b.y); o.w = pack2(b.z, b.w);
    ((uint4*)dst)[i] = o;
  }
}

DEV float wmax(float v) {
  v = fmaxf(v, __shfl_xor(v, 32)); v = fmaxf(v, __shfl_xor(v, 16)); v = fmaxf(v, __shfl_xor(v, 8));
  v = fmaxf(v, __shfl_xor(v, 4));  v = fmaxf(v, __shfl_xor(v, 2));  v = fmaxf(v, __shfl_xor(v, 1));
  return v;
}
DEV int wsum_i(int v) {
  v += __shfl_xor(v, 32); v += __shfl_xor(v, 16); v += __shfl_xor(v, 8);
  v += __shfl_xor(v, 4);  v += __shfl_xor(v, 2);  v += __shfl_xor(v, 1);
  return v;
}
DEV unsigned q4(float a, float b, float c, float d, float inv, int off) {
  int qa = (int)rintf(a * inv), qb = (int)rintf(b * inv), qc = (int)rintf(c * inv), qd = (int)rintf(d * inv);
  qa = min(max(qa, -127), 127) + off; qb = min(max(qb, -127), 127) + off;
  qc = min(max(qc, -127), 127) + off; qd = min(max(qd, -127), 127) + off;
  return (unsigned)(qa & 255) | ((unsigned)(qb & 255) << 8) | ((unsigned)(qc & 255) << 16) | ((unsigned)(qd & 255) << 24);
}
__device__ void quant_rows_f32(const float* __restrict__ src, unsigned char* __restrict__ dst, float* __restrict__ scales,
                               int nrows, int off) {
  const int lane = tid_() & 63, wid = tid_() >> 6;
  for (int row = bid_() * 4 + wid; row < nrows; row += gdim_() * 4) {
    const float* r = src + (size_t)row * 2048 + lane * 16;
    float v[32];
#pragma unroll
    for (int hf = 0; hf < 2; ++hf)
#pragma unroll
      for (int c = 0; c < 4; ++c) {
        float4 x = *(const float4*)(r + hf * 1024 + c * 4);
        v[hf * 16 + c * 4 + 0] = x.x; v[hf * 16 + c * 4 + 1] = x.y; v[hf * 16 + c * 4 + 2] = x.z; v[hf * 16 + c * 4 + 3] = x.w;
      }
    float am = 0.f;
#pragma unroll
    for (int e = 0; e < 32; ++e) am = fmaxf(am, fabsf(v[e]));
    am = wmax(am);
    const float sc = am > 0.f ? am * (1.f / 127.f) : 1.f;
    const float inv = 1.f / sc;
#pragma unroll
    for (int hf = 0; hf < 2; ++hf) {
      u32x4 o;
      o.x = q4(v[hf * 16 + 0], v[hf * 16 + 1], v[hf * 16 + 2], v[hf * 16 + 3], inv, off);
      o.y = q4(v[hf * 16 + 4], v[hf * 16 + 5], v[hf * 16 + 6], v[hf * 16 + 7], inv, off);
      o.z = q4(v[hf * 16 + 8], v[hf * 16 + 9], v[hf * 16 + 10], v[hf * 16 + 11], inv, off);
      o.w = q4(v[hf * 16 + 12], v[hf * 16 + 13], v[hf * 16 + 14], v[hf * 16 + 15], inv, off);
      *(u32x4*)(dst + (size_t)row * 2048 + hf * 1024 + lane * 16) = o;
    }
    if (lane == 0) scales[row] = sc;
  }
}

__device__ void quant_rows_bf16(const u16* __restrict__ src, u8* __restrict__ dst, float* __restrict__ scales, int nrows) {
  const int lane = tid_() & 63, wid = tid_() >> 6;
  for (int row = bid_() * 4 + wid; row < nrows; row += gdim_() * 4) {
    const u16* r = src + (size_t)row * 2048 + lane * 16;
    float v[32];
    {
      u32x4 a = *(const u32x4*)r, b = *(const u32x4*)(r + 8), c = *(const u32x4*)(r + 1024), d = *(const u32x4*)(r + 1032);
      v[0] = bflo(a.x); v[1] = bfhi(a.x); v[2] = bflo(a.y); v[3] = bfhi(a.y); v[4] = bflo(a.z); v[5] = bfhi(a.z); v[6] = bflo(a.w); v[7] = bfhi(a.w);
      v[8] = bflo(b.x); v[9] = bfhi(b.x); v[10] = bflo(b.y); v[11] = bfhi(b.y); v[12] = bflo(b.z); v[13] = bfhi(b.z); v[14] = bflo(b.w); v[15] = bfhi(b.w);
      v[16] = bflo(c.x); v[17] = bfhi(c.x); v[18] = bflo(c.y); v[19] = bfhi(c.y); v[20] = bflo(c.z); v[21] = bfhi(c.z); v[22] = bflo(c.w); v[23] = bfhi(c.w);
      v[24] = bflo(d.x); v[25] = bfhi(d.x); v[26] = bflo(d.y); v[27] = bfhi(d.y); v[28] = bflo(d.z); v[29] = bfhi(d.z); v[30] = bflo(d.w); v[31] = bfhi(d.w);
    }
    float am = 0.f;
#pragma unroll
    for (int e = 0; e < 32; ++e) am = fmaxf(am, fabsf(v[e]));
    am = wmax(am);
    const float sc = am > 0.f ? am * (1.f / 127.f) : 1.f;
    const float inv = 1.f / sc;
#pragma unroll
    for (int hf = 0; hf < 2; ++hf) {
      u32x4 o;
      o.x = q4(v[hf * 16 + 0], v[hf * 16 + 1], v[hf * 16 + 2], v[hf * 16 + 3], inv, 0);
      o.y = q4(v[hf * 16 + 4], v[hf * 16 + 5], v[hf * 16 + 6], v[hf * 16 + 7], inv, 0);
      o.z = q4(v[hf * 16 + 8], v[hf * 16 + 9], v[hf * 16 + 10], v[hf * 16 + 11], inv, 0);
      o.w = q4(v[hf * 16 + 12], v[hf * 16 + 13], v[hf * 16 + 14], v[hf * 16 + 15], inv, 0);
      *(u32x4*)(dst + (size_t)row * 2048 + hf * 1024 + lane * 16) = o;
    }
    if (lane == 0) scales[row] = sc;
  }
}

__device__ void transpose_convert(const float* __restrict__ src, int K, int N, u16* __restrict__ dst, char* smem) {
  float* tile = (float*)smem;
  const int tilesN = N >> 6, ntiles = (K >> 6) * tilesN;
  const int tid = tid_();
  for (int t = bid_(); t < ntiles; t += gdim_()) {
    const int k0 = (t / tilesN) << 6, n0 = (t % tilesN) << 6;
    __syncthreads();
    const int ty = tid >> 4, tx = tid & 15;
#pragma unroll
    for (int pp = 0; pp < 4; ++pp) {
      int k = ty + 16 * pp;
      float4 v = *(const float4*)(src + (size_t)(k0 + k) * N + n0 + tx * 4);
      float* d = tile + k * 65 + tx * 4;
      d[0] = v.x; d[1] = v.y; d[2] = v.z; d[3] = v.w;
    }
    __syncthreads();
    const int n = tid >> 2, ks = (tid & 3) * 16;
    unsigned o[8];
#pragma unroll
    for (int e = 0; e < 8; ++e) o[e] = pack2(tile[(ks + 2 * e) * 65 + n], tile[(ks + 2 * e + 1) * 65 + n]);
    uint4* d = (uint4*)(dst + (size_t)(n0 + n) * K + k0 + ks);
    d[0] = make_uint4(o[0], o[1], o[2], o[3]);
    d[1] = make_uint4(o[4], o[5], o[6], o[7]);
  }
}

DEV f32x4 mma_step(bf16x8 a, bf16x8 b, f32x4 c) { return MFMA(a, b, c); }
DEV i32x4 mma_step(i32x4 a, i32x4 b, i32x4 c) { return __builtin_amdgcn_mfma_i32_16x16x64_i8(a, b, c, 0, 0, 0); }

template <class FragT, class AccT>
DEV void gemm_core_t(const char* __restrict__ A, size_t lda_bytes, const char* __restrict__ Bt, size_t ldb_bytes, int kbytes,
                     int m0, int n0, int Sshift, int dl, char* smem, AccT (&acc)[4][4]) {
  const int tid = tid_(), lane = tid & 63, wid = tid >> 6, wm = wid >> 1, wn = wid & 1;
  const int l15 = lane & 15, q = lane >> 4;
  const int srow = lane >> 3, schunk = (lane & 7) ^ (lane >> 3);
  const char* ap[4];
  const char* bp[4];
#pragma unroll
  for (int u = 0; u < 4; ++u) {
    int r = (wid * 4 + u) * 8 + srow;
    int ar = rowmap(m0 + r, Sshift, dl);
    ap[u] = A + (size_t)ar * lda_bytes + schunk * 16;
    bp[u] = Bt + (size_t)(n0 + r) * ldb_bytes + schunk * 16;
  }
#pragma unroll
  for (int i = 0; i < 4; ++i)
#pragma unroll
    for (int j = 0; j < 4; ++j) acc[i][j] = AccT{0, 0, 0, 0};
  const int nk = kbytes >> 7;
  __syncthreads();
#pragma unroll
  for (int u = 0; u < 4; ++u) {
    __builtin_amdgcn_global_load_lds((const unsigned*)ap[u], (unsigned*)(smem + (wid * 4 + u) * 1024 + lane * 16), 16, 0, 0);
    __builtin_amdgcn_global_load_lds((const unsigned*)bp[u], (unsigned*)(smem + 16384 + (wid * 4 + u) * 1024 + lane * 16), 16, 0, 0);
  }
  const unsigned sbase = (unsigned)(unsigned long)((__attribute__((address_space(3))) char*)smem);
  const unsigned sq0 = (unsigned)((q ^ (l15 & 7)) << 4);
  const unsigned a0 = sbase + (unsigned)((wm * 64 + l15) * 128) + sq0;
  const unsigned b0 = sbase + 16384u + (unsigned)((wn * 32 + l15) * 128) + sq0;
  asm volatile("s_waitcnt vmcnt(0)" ::: "memory");
  __syncthreads();
  for (int kt = 0; kt < nk; ++kt) {
    const unsigned so = (unsigned)(kt & 1) * 32768u;
    char* nxt = smem + ((kt + 1) & 1) * 32768;
    if (kt + 1 < nk) {
#pragma unroll
      for (int u = 0; u < 4; ++u) {
        __builtin_amdgcn_global_load_lds((const unsigned*)(ap[u] + (size_t)(kt + 1) * 128), (unsigned*)(nxt + (wid * 4 + u) * 1024 + lane * 16), 16, 0, 0);
        __builtin_amdgcn_global_load_lds((const unsigned*)(bp[u] + (size_t)(kt + 1) * 128), (unsigned*)(nxt + 16384 + (wid * 4 + u) * 1024 + lane * 16), 16, 0, 0);
      }
    }
    FragT xa[2][4], wb[2][4];
    asm volatile(
        "ds_read_b128 %0, %16\n\t"
        "ds_read_b128 %1, %16 offset:2048\n\t"
        "ds_read_b128 %2, %16 offset:4096\n\t"
        "ds_read_b128 %3, %16 offset:6144\n\t"
        "ds_read_b128 %4, %18\n\t"
        "ds_read_b128 %5, %18 offset:2048\n\t"
        "ds_read_b128 %6, %18 offset:8192\n\t"
        "ds_read_b128 %7, %18 offset:10240\n\t"
        "ds_read_b128 %8, %17\n\t"
        "ds_read_b128 %9, %17 offset:2048\n\t"
        "ds_read_b128 %10, %17 offset:4096\n\t"
        "ds_read_b128 %11, %17 offset:6144\n\t"
        "ds_read_b128 %12, %19\n\t"
        "ds_read_b128 %13, %19 offset:2048\n\t"
        "ds_read_b128 %14, %19 offset:8192\n\t"
        "ds_read_b128 %15, %19 offset:10240\n\t"
        "s_waitcnt lgkmcnt(8)"
        : "=&v"(xa[0][0]), "=&v"(xa[0][1]), "=&v"(xa[0][2]), "=&v"(xa[0][3]), "=&v"(wb[0][0]), "=&v"(wb[0][1]), "=&v"(wb[0][2]),
          "=&v"(wb[0][3]), "=&v"(xa[1][0]), "=&v"(xa[1][1]), "=&v"(xa[1][2]), "=&v"(xa[1][3]), "=&v"(wb[1][0]), "=&v"(wb[1][1]),
          "=&v"(wb[1][2]), "=&v"(wb[1][3])
        : "v"(a0 + so), "v"((a0 ^ 64u) + so), "v"(b0 + so), "v"((b0 ^ 64u) + so)
        : "memory");
    __builtin_amdgcn_s_setprio(1);
#pragma unroll
    for (int i = 0; i < 4; ++i)
#pragma unroll
      for (int j = 0; j < 4; ++j) acc[i][j] = mma_step(wb[0][j], xa[0][i], acc[i][j]);
    asm volatile("s_waitcnt lgkmcnt(0)"
                 : "+v"(xa[1][0]), "+v"(xa[1][1]), "+v"(xa[1][2]), "+v"(xa[1][3]), "+v"(wb[1][0]), "+v"(wb[1][1]), "+v"(wb[1][2]),
                   "+v"(wb[1][3]), "+v"(acc[0][0]), "+v"(acc[0][1]), "+v"(acc[0][2]), "+v"(acc[0][3]), "+v"(acc[1][0]),
                   "+v"(acc[1][1]), "+v"(acc[1][2]), "+v"(acc[1][3]), "+v"(acc[2][0]), "+v"(acc[2][1]), "+v"(acc[2][2]),
                   "+v"(acc[2][3]), "+v"(acc[3][0]), "+v"(acc[3][1]), "+v"(acc[3][2]), "+v"(acc[3][3])
                 :
                 : "memory");
#pragma unroll
    for (int i = 0; i < 4; ++i)
#pragma unroll
      for (int j = 0; j < 4; ++j) acc[i][j] = mma_step(wb[1][j], xa[1][i], acc[i][j]);
    __builtin_amdgcn_s_setprio(0);
    asm volatile("s_waitcnt vmcnt(0)"
                 : "+v"(acc[0][0]), "+v"(acc[0][1]), "+v"(acc[0][2]), "+v"(acc[0][3]), "+v"(acc[1][0]), "+v"(acc[1][1]),
                   "+v"(acc[1][2]), "+v"(acc[1][3]), "+v"(acc[2][0]), "+v"(acc[2][1]), "+v"(acc[2][2]), "+v"(acc[2][3]),
                   "+v"(acc[3][0]), "+v"(acc[3][1]), "+v"(acc[3][2]), "+v"(acc[3][3])
                 :
                 : "memory");
    __syncthreads();
  }
}

DEV void gemm_core(const u16* __restrict__ A, int lda, const u16* __restrict__ Bt, int ldb, int K, int m0, int n0,
                   int Sshift, int dl, char* smem, f32x4 (&acc)[4][4]) {
  gemm_core_t<bf16x8, f32x4>((const char*)A, (size_t)lda * 2, (const char*)Bt, (size_t)ldb * 2, K * 2, m0, n0, Sshift, dl, smem, acc);
}
DEV void gemm_core_i8(const u8* __restrict__ A, int lda, const u8* __restrict__ Bt, int ldb, int K, int m0, int n0,
                      int Sshift, int dl, char* smem, i32x4 (&acc)[4][4]) {
  gemm_core_t<i32x4, i32x4>((const char*)A, (size_t)lda, (const char*)Bt, (size_t)ldb, K, m0, n0, Sshift, dl, smem, acc);
}

DEV void tile_map(int t, int ntx, int& mt, int& nt) {
  int x = t & 7, u = t >> 3;
  int grp = u / (8 * ntx), rem = u % (8 * ntx);
  nt = x * ntx + (rem >> 3);
  mt = grp * 8 + (rem & 7);
}

DEV void store_nat(u16* buf, int ld, int row, int col, f32x4 v) {
  uint2 o; o.x = pack2(v[0], v[1]); o.y = pack2(v[2], v[3]);
  *(uint2*)(buf + (size_t)row * ld + col) = o;
}
DEV void store_tr(u16* buf, int col, int m, f32x4 v) {
#pragma unroll
  for (int r = 0; r < 4; ++r) buf[(size_t)(col + r) * TS + m] = f2bf(v[r]);
}

DEV void stage_tile_bf16(char* smem, const f32x4 (&v)[4][4], u16* buf, int ld, int m0, int col0) {
  const int tid = tid_(), lane = tid & 63, wid = tid >> 6, wm = wid >> 1, wn = wid & 1, l15 = lane & 15, q = lane >> 4;
#pragma unroll
  for (int i = 0; i < 4; ++i)
#pragma unroll
    for (int j = 0; j < 4; ++j) {
      const int rl = wm * 64 + i * 16 + l15, cl = (j & 1) * 16 + wn * 32 + (j >> 1) * 64 + q * 4;
      u32x2 o; o.x = pack2(v[i][j][0], v[i][j][1]); o.y = pack2(v[i][j][2], v[i][j][3]);
      *(u32x2*)(smem + rl * 272 + cl * 2) = o;
    }
  __syncthreads();
#pragma unroll
  for (int k = 0; k < 8; ++k) {
    const int chunk = tid + 256 * k, rl = chunk >> 4, c16 = chunk & 15;
    u32x4 d = *(const u32x4*)(smem + rl * 272 + c16 * 16);
    *(u32x4*)(buf + (size_t)(m0 + rl) * ld + col0 + c16 * 8) = d;
  }
}

__device__ __forceinline__ void phase_gemm1(PREF P, int slab, char* smem) {
  const int Sshift = slab < 2 ? 12 : 13;
  const int lane = tid_() & 63, wid = tid_() >> 6, wm = wid >> 1, wn = wid & 1, l15 = lane & 15, q = lane >> 4;
  for (int t = bid_(); t < 64 * 152; t += gdim_()) {
    int mt, nt;
    tile_map(t, 19, mt, nt);
    const int m0 = mt * 128, n0 = nt * 128;
    int region, dl = 0;
    if (n0 < 1024) region = 0;
    else if (n0 < 2048) region = 1;
    else if (n0 < 4096) region = 2;
    else if (n0 < 6144) region = 3;
    else if (n0 < 9216) region = 4;
    else if (n0 < 12288) region = 5;
    else if (n0 < 15360) region = 6;
    else if (n0 < 17408) region = 7;
    else region = 8;
    if (region >= 4 && region <= 6) dl = 2 * ((n0 - (6144 + (region - 4) * 3072)) >> 10);
    f32x4 acc[4][4];
    {
      i32x4 iacc[4][4];
      gemm_core_i8(P.xq8, DM, P.Win8, DM, DM, m0, n0, Sshift, dl, smem, iacc);
#pragma unroll
      for (int i = 0; i < 4; ++i) {
        const float sxr = P.sx[rowmap(m0 + wm * 64 + i * 16 + l15, Sshift, dl)];
#pragma unroll
        for (int j = 0; j < 4; ++j) {
          const float4 swc = *(const float4*)(P.sw + n0 + (j & 1) * 16 + wn * 32 + (j >> 1) * 64 + q * 4);
          acc[i][j][0] = (float)iacc[i][j][0] * sxr * swc.x; acc[i][j][1] = (float)iacc[i][j][1] * sxr * swc.y;
          acc[i][j][2] = (float)iacc[i][j][2] * sxr * swc.z; acc[i][j][3] = (float)iacc[i][j][3] * sxr * swc.w;
        }
      }
    }
    if (region <= 1) {
#pragma unroll
      for (int i = 0; i < 4; ++i) {
        const int row = m0 + wm * 64 + i * 16 + l15;
        const float s = (float)(row & ((1 << Sshift) - 1));
#pragma unroll
        for (int jj = 0; jj < 2; ++jj)
#pragma unroll
          for (int r = 0; r < 4; ++r) {
            const int d = jj * 16 + wn * 32 + q * 4 + r;
            float fr = __builtin_amdgcn_fractf(s * P.ropec[d]);
            float cs = __builtin_amdgcn_cosf(fr), sn = __builtin_amdgcn_sinf(fr);
            float t1 = acc[i][jj][r], t2 = acc[i][jj + 2][r];
            float o1 = t1 * cs - t2 * sn, o2 = t1 * sn + t2 * cs;
            if (region == 1) { o1 *= QK_SCALE; o2 *= QK_SCALE; }
            acc[i][jj][r] = o1;
            acc[i][jj + 2][r] = o2;
          }
      }
    }
    u16* nbuf = nullptr; int nld = 0, ncol = 0;
    u16* tbuf = nullptr; int tcol = 0;
    switch (region) {
      case 0: nbuf = P.Qr; nld = 1024; ncol = n0; break;
      case 1: nbuf = P.Kr; nld = 1024; ncol = n0 - 1024; tbuf = P.KrT; tcol = n0 - 1024; break;
      case 2: tbuf = P.VrT; tcol = n0 - 2048; break;
      case 3: nbuf = P.Rg; nld = 2048; ncol = n0 - 4096; break;
      case 4: nbuf = P.AQ; nld = 3072; ncol = n0 - 6144; break;
      case 5: nbuf = P.AK; nld = 3072; ncol = n0 - 9216; break;
      case 6: tbuf = P.AVT; tcol = n0 - 12288; break;
      default: break;
    }
    if (region == 4) {
#pragma unroll
      for (int i = 0; i < 4; ++i)
#pragma unroll
        for (int j = 0; j < 4; ++j) acc[i][j] = acc[i][j] * QK_SCALE;
    }
    const int tid = tid_();
    if (region >= 7) {
      u8* gb8 = (u8*)(region == 7 ? P.GA : P.GB);
      const int gcol = n0 - (region == 7 ? 15360 : 17408);
#pragma unroll
      for (int i = 0; i < 4; ++i)
#pragma unroll
        for (int j = 0; j < 4; ++j) {
          const int rl = wm * 64 + i * 16 + l15, cl = (j & 1) * 16 + wn * 32 + (j >> 1) * 64 + q * 4;
          const unsigned b0 = (unsigned)(sigm(acc[i][j][0]) * 255.f + 0.5f), b1 = (unsigned)(sigm(acc[i][j][1]) * 255.f + 0.5f);
          const unsigned b2 = (unsigned)(sigm(acc[i][j][2]) * 255.f + 0.5f), b3 = (unsigned)(sigm(acc[i][j][3]) * 255.f + 0.5f);
          *(unsigned*)(smem + rl * 144 + cl) = b0 | (b1 << 8) | (b2 << 16) | (b3 << 24);
        }
      __syncthreads();
#pragma unroll
      for (int k = 0; k < 4; ++k) {
        const int chunk = tid + 256 * k, rl = chunk >> 3, c16 = chunk & 7;
        u32x4 d = *(const u32x4*)(smem + rl * 144 + c16 * 16);
        __builtin_nontemporal_store(d, (u32x4*)(gb8 + (size_t)(m0 + rl) * 2048 + gcol + c16 * 16));
      }
    }
    if (nbuf) {
#pragma unroll
      for (int i = 0; i < 4; ++i)
#pragma unroll
        for (int j = 0; j < 4; ++j) {
          const int rl = wm * 64 + i * 16 + l15, cl = (j & 1) * 16 + wn * 32 + (j >> 1) * 64 + q * 4;
          u32x2 o; o.x = pack2(acc[i][j][0], acc[i][j][1]); o.y = pack2(acc[i][j][2], acc[i][j][3]);
          *(u32x2*)(smem + rl * 272 + cl * 2) = o;
        }
      __syncthreads();
#pragma unroll
      for (int k = 0; k < 8; ++k) {
        const int chunk = tid + 256 * k, rl = chunk >> 4, c16 = chunk & 15;
        u32x4 d = *(const u32x4*)(smem + rl * 272 + c16 * 16);
        __builtin_nontemporal_store(d, (u32x4*)(nbuf + (size_t)(m0 + rl) * nld + ncol + c16 * 8));
      }
      if (tbuf) __syncthreads();
    }
    if (tbuf) {
#pragma unroll
      for (int i = 0; i < 4; ++i)
#pragma unroll
        for (int j = 0; j < 4; ++j) {
          const int rl = wm * 64 + i * 16 + l15, cl = (j & 1) * 16 + wn * 32 + (j >> 1) * 64 + q * 4;
#pragma unroll
          for (int r = 0; r < 4; ++r) *(u16*)(smem + (cl + r) * 272 + rl * 2) = f2bf(acc[i][j][r]);
        }
      __syncthreads();
#pragma unroll
      for (int k = 0; k < 8; ++k) {
        const int chunk = tid + 256 * k, cl = chunk >> 4, c16 = chunk & 15;
        u32x4 d = *(const u32x4*)(smem + cl * 272 + c16 * 16);
        __builtin_nontemporal_store(d, (u32x4*)(tbuf + (size_t)(tcol + cl) * TS + m0 + c16 * 8));
      }
    }
  }
}

template <class F>
DEV void dma_rows256(F rowptr, int nrows, char* lds) {
  const int lane = tid_() & 63, wid = tid_() >> 6;
  for (int blk = wid; blk < (nrows >> 2); blk += 4) {
    const int row = blk * 4 + (lane >> 4);
    const int c = (lane & 15) ^ (row & 15);
    const u16* src = rowptr(row) + c * 8;
    __builtin_amdgcn_global_load_lds((const unsigned*)src, (unsigned*)(lds + blk * 1024 + lane * 16), 16, 0, 0);
  }
}
DEV bf16x8 rd128(const char* lds, int row, int chunk) {
  return *(const bf16x8*)(lds + row * 256 + ((chunk ^ (row & 15)) << 4));
}
DEV u32x2 rd64(const char* lds, int row, int byteoff) {
  return *(const u32x2*)(lds + row * 256 + ((((byteoff >> 4)) ^ (row & 15)) << 4) + (byteoff & 15));
}
#define DMA_WAIT_SYNC() do { asm volatile("s_waitcnt vmcnt(0)" ::: "memory"); __syncthreads(); } while (0)

__device__ __forceinline__ void ret_kv_item(PREF P, int w, u16* ST, char* smem) {
  const int lane = tid_() & 63, wid = tid_() >> 6, l15 = lane & 15, q = lane >> 4;
  const int dir = w & 1, h = (w >> 1) & 7, n = w >> 4;
  const int tok0 = n * 128;
  const float l2 = log_sigmoid(P.decay_logit[dir * 8 + h]) * LOG2E;
  __syncthreads();
  {
    const u16* kt = P.KrT + (size_t)(h * 128) * TS + tok0;
    dma_rows256([&](int row) { return kt + (size_t)row * TS; }, 128, smem);
  }
  u32x4 vraw[4][4];
  {
    const u16* vbase = P.VrT + (size_t)(h * 256 + wid * 64 + l15) * TS + tok0 + q * 8;
#pragma unroll
    for (int kk = 0; kk < 4; ++kk)
#pragma unroll
      for (int jd = 0; jd < 4; ++jd) vraw[kk][jd] = *(const u32x4*)(vbase + (size_t)jd * 16 * TS + kk * 32);
  }
  f32x4 acc[8][4];
#pragma unroll
  for (int a = 0; a < 8; ++a)
#pragma unroll
    for (int b = 0; b < 4; ++b) acc[a][b] = f32x4{0.f, 0.f, 0.f, 0.f};
  DMA_WAIT_SYNC();
#pragma unroll
  for (int kk = 0; kk < 4; ++kk) {
    const int tb = kk * 32 + q * 8;
    float z[8];
#pragma unroll
    for (int e = 0; e < 8; ++e) {
      int t = tb + e;
      z[e] = __builtin_amdgcn_exp2f(l2 * (float)(dir == 0 ? 127 - t : t));
    }
    bf16x8 vb[4];
#pragma unroll
    for (int jd = 0; jd < 4; ++jd) {
      u32x4 raw = vraw[kk][jd];
      u32x4 o;
      o.x = pack2(bflo(raw.x) * z[0], bfhi(raw.x) * z[1]);
      o.y = pack2(bflo(raw.y) * z[2], bfhi(raw.y) * z[3]);
      o.z = pack2(bflo(raw.z) * z[4], bfhi(raw.z) * z[5]);
      o.w = pack2(bflo(raw.w) * z[6], bfhi(raw.w) * z[7]);
      vb[jd] = __builtin_bit_cast(bf16x8, o);
    }
#pragma unroll
    for (int ik = 0; ik < 8; ++ik) {
      bf16x8 ka = rd128(smem, ik * 16 + l15, kk * 4 + q);
#pragma unroll
      for (int jd = 0; jd < 4; ++jd) acc[ik][jd] = MFMA(ka, vb[jd], acc[ik][jd]);
    }
  }
  u16* dst = ST + ((size_t)((n * 8 + h) * 2 + dir)) * 32768;
#pragma unroll
  for (int ik = 0; ik < 8; ++ik)
#pragma unroll
    for (int jd = 0; jd < 4; ++jd) {
      uint2 o; o.x = pack2(acc[ik][jd][0], acc[ik][jd][1]); o.y = pack2(acc[ik][jd][2], acc[ik][jd][3]);
      *(uint2*)(dst + (size_t)(wid * 64 + jd * 16 + l15) * 128 + ik * 16 + q * 4) = o;
    }
}

__device__ __forceinline__ void attn_item(PREF P, int w, int Sshift, char* smem) {
  const int lane = tid_() & 63, wid = tid_() >> 6, l15 = lane & 15, q = lane >> 4;
  const int qb = w & 127, hs = (w >> 7) & 7, gi = w >> 10;
  const int dl = gi * 2, Lshift = Sshift - dl, L = 1 << Lshift;
  const int p0 = qb * 64, l0 = p0 & (L - 1), pbase = p0 - l0;
  const int hcol = (gi * 8 + hs) * 128;
  const int li = l0 + wid * 16 + l15;
  char* KW = smem;
  char* VH = smem + 49152;
  auto dma_vhalf = [&](char* dstb, int half) {
    for (int ins = wid; ins < 25; ins += 4) {
      const int sl = ins * 64 + lane;
      const int row = sl / 25;
      int cp = sl - row * 25;
      if (cp == 24) cp = 0;
      int l = l0 - 64 + cp * 8;
      if (l < 0 || l >= L) l = 0;
      const u16* src = P.AVT + (size_t)(hcol + half * 64 + row) * TS + pbase + l;
      __builtin_amdgcn_global_load_lds((const unsigned*)src, (unsigned*)(dstb + ins * 1024 + lane * 16), 16, 0, 0);
    }
  };
  __syncthreads();
  {
    const u16* kb = P.AK + (size_t)pbase * 3072 + hcol;
    dma_rows256([&](int row) { int l = min(max(l0 - 64 + row, 0), L - 1); return kb + (size_t)l * 3072; }, 192, KW);
  }
  dma_vhalf(VH, 0);
  bf16x8 qf[4];
  {
    const u16* qrow = P.AQ + (size_t)(pbase + li) * 3072 + hcol + q * 8;
#pragma unroll
    for (int kd = 0; kd < 4; ++kd) qf[kd] = *(const bf16x8*)(qrow + kd * 32);
  }
  const int kstart = l0 + wid * 16 - 64;
  const float* brow = P.biasT + (gi * 8 + hs) * 129 + 64;
  float bv[10][4];
#pragma unroll
  for (int jt = 0; jt < 10; ++jt)
#pragma unroll
    for (int r = 0; r < 4; ++r) {
      int off = kstart + jt * 16 + q * 4 + r - li;
      bv[jt][r] = brow[min(max(off, -64), 64)];
    }
  DMA_WAIT_SYNC();
  f32x4 sT[10];
#pragma unroll
  for (int jt = 0; jt < 10; ++jt) {
    const int krow = min(wid * 16 + jt * 16 + l15, 191);
    f32x4 sa = {0.f, 0.f, 0.f, 0.f};
#pragma unroll
    for (int kd = 0; kd < 4; ++kd) sa = MFMA(rd128(KW, krow, kd * 4 + q), qf[kd], sa);
    sT[jt] = sa;
  }
  __syncthreads();
  dma_vhalf(KW, 1);
  float mx = -1e30f;
#pragma unroll
  for (int jt = 0; jt < 10; ++jt)
#pragma unroll
    for (int r = 0; r < 4; ++r) {
      int lk = kstart + jt * 16 + q * 4 + r;
      int off = lk - li;
      bool valid = (off >= -64) && (off <= 64) && (lk >= 0) && (lk < L);
      float lg = valid ? sT[jt][r] + bv[jt][r] : -1e30f;
      sT[jt][r] = lg;
      mx = fmaxf(mx, lg);
    }
  mx = fmaxf(mx, __shfl_xor(mx, 16));
  mx = fmaxf(mx, __shfl_xor(mx, 32));
  float den = 0.f;
#pragma unroll
  for (int jt = 0; jt < 10; ++jt)
#pragma unroll
    for (int r = 0; r < 4; ++r) {
      float lg = sT[jt][r];
      float p = (lg > -1e29f) ? __expf(lg - mx) : 0.f;
      sT[jt][r] = p;
      den += p;
    }
  den += __shfl_xor(den, 16);
  den += __shfl_xor(den, 32);
  bf16x8 pf[5];
#pragma unroll
  for (int j2 = 0; j2 < 5; ++j2) {
    u32x4 pp;
    pp.x = pack2(sT[2 * j2][0], sT[2 * j2][1]);
    pp.y = pack2(sT[2 * j2][2], sT[2 * j2][3]);
    pp.z = pack2(sT[2 * j2 + 1][0], sT[2 * j2 + 1][1]);
    pp.w = pack2(sT[2 * j2 + 1][2], sT[2 * j2 + 1][3]);
    pf[j2] = __builtin_bit_cast(bf16x8, pp);
  }
  const float inv = 1.f / den;
  u16* orow = P.og + ((size_t)gi * TS + pbase + li) * 1024 + hs * 128 + q * 4;
#pragma unroll 1
  for (int half = 0; half < 2; ++half) {
    const char* vb = half == 0 ? VH : KW;
    if (half == 1) DMA_WAIT_SYNC();
    f32x4 oT[4];
#pragma unroll
    for (int d = 0; d < 4; ++d) oT[d] = f32x4{0.f, 0.f, 0.f, 0.f};
#pragma unroll
    for (int j2 = 0; j2 < 5; ++j2) {
      int ia = wid * 16 + j2 * 32 + q * 4;
      int ib = ia + 16;
      if (ia >= 192) ia = 0;
      if (ib >= 192) ib = 0;
#pragma unroll
      for (int dvt = 0; dvt < 4; ++dvt) {
        const char* vrow = vb + (dvt * 16 + l15) * 400;
        u32x2 a0 = *(const u32x2*)(vrow + ia * 2), a1 = *(const u32x2*)(vrow + ib * 2);
        u32x4 vv = {a0.x, a0.y, a1.x, a1.y};
        oT[dvt] = MFMA(__builtin_bit_cast(bf16x8, vv), pf[j2], oT[dvt]);
      }
    }
#pragma unroll
    for (int dvt = 0; dvt < 4; ++dvt) {
      uint2 o;
      o.x = pack2(oT[dvt][0] * inv, oT[dvt][1] * inv);
      o.y = pack2(oT[dvt][2] * inv, oT[dvt][3] * inv);
      *(uint2*)(orow + half * 64 + dvt * 16) = o;
    }
  }
  if (q == 0) P.lse[((size_t)gi * TS + pbase + li) * 8 + hs] = mx + logf(den);
}

__device__ __forceinline__ void phase_scan(PREF P, int slab, u16* ST) {
  const int Sshift = slab < 2 ? 12 : 13;
  const int nseq = TS >> Sshift, nC = 1 << (Sshift - 7);
  const int nitems = nseq * 16 * 4096;
  for (int idx = bid_() * NTHR + tid_(); idx < nitems; idx += gdim_() * NTHR) {
    const int e8 = idx & 4095, hd = (idx >> 12) & 15, seq = idx >> 16;
    const int dir = hd & 1, h = hd >> 1;
    const float dec = expf(log_sigmoid(P.decay_logit[dir * 8 + h]) * 128.f);
    float R[8];
#pragma unroll
    for (int e = 0; e < 8; ++e) R[e] = 0.f;
    u16* base = ST + (size_t)hd * 32768 + e8 * 8;
    for (int cc = 0; cc < nC; cc += 4) {
      uint4 v[4];
#pragma unroll
      for (int u = 0; u < 4; ++u) {
        int c = dir == 0 ? (cc + u) : (nC - 1 - cc - u);
        v[u] = *(const uint4*)(base + (size_t)(seq * nC + c) * (16 * 32768));
      }
#pragma unroll
      for (int u = 0; u < 4; ++u) {
        int c = dir == 0 ? (cc + u) : (nC - 1 - cc - u);
        uint4 o;
        o.x = pack2(R[0], R[1]); o.y = pack2(R[2], R[3]); o.z = pack2(R[4], R[5]); o.w = pack2(R[6], R[7]);
        *(uint4*)(base + (size_t)(seq * nC + c) * (16 * 32768)) = o;
        R[0] = R[0] * dec + bflo(v[u].x); R[1] = R[1] * dec + bfhi(v[u].x);
        R[2] = R[2] * dec + bflo(v[u].y); R[3] = R[3] * dec + bfhi(v[u].y);
        R[4] = R[4] * dec + bflo(v[u].z); R[5] = R[5] * dec + bfhi(v[u].z);
        R[6] = R[6] * dec + bflo(v[u].w); R[7] = R[7] * dec + bfhi(v[u].w);
      }
    }
  }
}

DEV unsigned lds_off(const char* p) { return (unsigned)(unsigned long)((__attribute__((address_space(3))) const char*)p); }
DEV void ro_pv(const char* buf, const bf16x8 (&pf)[4], f32x4 (&oT)[8], int l15, int q) {
#pragma unroll
  for (int d = 0; d < 8; ++d) oT[d] = f32x4{0.f, 0.f, 0.f, 0.f};
  const unsigned base = lds_off(buf) + (unsigned)(l15 * 256 + (q & 1) * 8);
#pragma unroll
  for (int j2 = 0; j2 < 4; ++j2) {
    const unsigned a0 = base + (unsigned)((((j2 * 4 + (q >> 1)) ^ l15) & 15) << 4);
    const unsigned a1 = base + (unsigned)((((j2 * 4 + (q >> 1) + 2) ^ l15) & 15) << 4);
    u32x2 v0[8], v1[8];
    asm volatile(
        "ds_read_b64 %0, %16\n\t"
        "ds_read_b64 %1, %16 offset:4096\n\t"
        "ds_read_b64 %2, %16 offset:8192\n\t"
        "ds_read_b64 %3, %16 offset:12288\n\t"
        "ds_read_b64 %4, %16 offset:16384\n\t"
        "ds_read_b64 %5, %16 offset:20480\n\t"
        "ds_read_b64 %6, %16 offset:24576\n\t"
        "ds_read_b64 %7, %16 offset:28672\n\t"
        "ds_read_b64 %8, %17\n\t"
        "ds_read_b64 %9, %17 offset:4096\n\t"
        "ds_read_b64 %10, %17 offset:8192\n\t"
        "ds_read_b64 %11, %17 offset:12288\n\t"
        "ds_read_b64 %12, %17 offset:16384\n\t"
        "ds_read_b64 %13, %17 offset:20480\n\t"
        "ds_read_b64 %14, %17 offset:24576\n\t"
        "ds_read_b64 %15, %17 offset:28672\n\t"
        "s_waitcnt lgkmcnt(0)"
        : "=&v"(v0[0]), "=&v"(v0[1]), "=&v"(v0[2]), "=&v"(v0[3]), "=&v"(v0[4]), "=&v"(v0[5]), "=&v"(v0[6]), "=&v"(v0[7]),
          "=&v"(v1[0]), "=&v"(v1[1]), "=&v"(v1[2]), "=&v"(v1[3]), "=&v"(v1[4]), "=&v"(v1[5]), "=&v"(v1[6]), "=&v"(v1[7])
        : "v"(a0), "v"(a1)
        : "memory");
#pragma unroll
    for (int dvt = 0; dvt < 8; ++dvt) {
      u32x4 vv = {v0[dvt].x, v0[dvt].y, v1[dvt].x, v1[dvt].y};
      oT[dvt] = MFMA(__builtin_bit_cast(bf16x8, vv), pf[j2], oT[dvt]);
    }
  }
}
DEV void ro_cross(const char* buf, float xi, const bf16x8 (&qf)[4], f32x4 (&oT)[8], int l15, int q) {
  const unsigned base = lds_off(buf) + (unsigned)(l15 * 256);
#pragma unroll
  for (int kd = 0; kd < 4; ++kd) {
    u32x4 raw = __builtin_bit_cast(u32x4, qf[kd]);
    u32x4 o;
    o.x = pack2(bflo(raw.x) * xi, bfhi(raw.x) * xi);
    o.y = pack2(bflo(raw.y) * xi, bfhi(raw.y) * xi);
    o.z = pack2(bflo(raw.z) * xi, bfhi(raw.z) * xi);
    o.w = pack2(bflo(raw.w) * xi, bfhi(raw.w) * xi);
    bf16x8 qs = __builtin_bit_cast(bf16x8, o);
    const unsigned a0 = base + (unsigned)((((kd * 4 + q) ^ l15) & 15) << 4);
    bf16x8 ra[8];
    asm volatile(
        "ds_read_b128 %0, %8\n\t"
        "ds_read_b128 %1, %8 offset:4096\n\t"
        "ds_read_b128 %2, %8 offset:8192\n\t"
        "ds_read_b128 %3, %8 offset:12288\n\t"
        "ds_read_b128 %4, %8 offset:16384\n\t"
        "ds_read_b128 %5, %8 offset:20480\n\t"
        "ds_read_b128 %6, %8 offset:24576\n\t"
        "ds_read_b128 %7, %8 offset:28672\n\t"
        "s_waitcnt lgkmcnt(0)"
        : "=&v"(ra[0]), "=&v"(ra[1]), "=&v"(ra[2]), "=&v"(ra[3]), "=&v"(ra[4]), "=&v"(ra[5]), "=&v"(ra[6]), "=&v"(ra[7])
        : "v"(a0)
        : "memory");
#pragma unroll
    for (int dvt = 0; dvt < 8; ++dvt) oT[dvt] = MFMA(ra[dvt], qs, oT[dvt]);
  }
}
#define RO_WAIT_SYNC() do { asm volatile("s_waitcnt vmcnt(0)" : "+v"(oT[0]), "+v"(oT[1]), "+v"(oT[2]), "+v"(oT[3]), \
    "+v"(oT[4]), "+v"(oT[5]), "+v"(oT[6]), "+v"(oT[7]) : : "memory"); __syncthreads(); } while (0)

__device__ __forceinline__ void ret_out_item(PREF P, int w, const u16* ST, char* smem) {
  const int lane = tid_() & 63, wid = tid_() >> 6, l15 = lane & 15, q = lane >> 4;
  const int rh = w & 1, h = (w >> 1) & 7, n = w >> 4;
  const int tok0 = n * 128;
  const int i = rh * 64 + wid * 16 + l15;
  const float l2f = log_sigmoid(P.decay_logit[h]) * LOG2E;
  const float l2b = log_sigmoid(P.decay_logit[8 + h]) * LOG2E;
  char* X = smem;
  char* Y = smem + 32768;
  const u16* kbase = P.Kr + (size_t)tok0 * 1024 + h * 128;
  const u16* vbase = P.VrT + (size_t)(h * 256) * TS + tok0;
  const u16* rbase = ST + ((size_t)((n * 8 + h) * 2)) * 32768;
#define RO_DMA_K(d) dma_rows256([&](int row) { return kbase + (size_t)row * 1024; }, 128, d)
#define RO_DMA_V(d, hf) dma_rows256([&](int row) { return vbase + (size_t)((hf) * 128 + row) * TS; }, 128, d)
#define RO_DMA_R(d, dir, hf) dma_rows256([&](int row) { return rbase + (size_t)(dir) * 32768 + (size_t)((hf) * 128 + row) * 128; }, 128, d)
  __syncthreads();
  RO_DMA_K(X);
  bf16x8 qf[4];
  {
    const u16* qrow = P.Qr + (size_t)(tok0 + i) * 1024 + h * 128 + q * 8;
#pragma unroll
    for (int kd = 0; kd < 4; ++kd) qf[kd] = *(const bf16x8*)(qrow + kd * 32);
  }
  const float xif = __builtin_amdgcn_exp2f(l2f * (float)(i + 1));
  const float xib = __builtin_amdgcn_exp2f(l2b * (float)(128 - i));
  DMA_WAIT_SYNC();
  RO_DMA_V(Y, 0);
  bf16x8 pf[4];
  {
    f32x4 sT[8];
#pragma unroll
    for (int jt = 0; jt < 8; ++jt) {
      sT[jt] = f32x4{0.f, 0.f, 0.f, 0.f};
#pragma unroll
      for (int kd = 0; kd < 4; ++kd) sT[jt] = MFMA(rd128(X, jt * 16 + l15, kd * 4 + q), qf[kd], sT[jt]);
    }
#pragma unroll
    for (int jt = 0; jt < 8; ++jt)
#pragma unroll
      for (int r = 0; r < 4; ++r) {
        int diff = i - (jt * 16 + q * 4 + r);
        float dcy = diff >= 0 ? __builtin_amdgcn_exp2f(l2f * (float)diff) : __builtin_amdgcn_exp2f(l2b * (float)(-diff));
        sT[jt][r] *= dcy;
      }
#pragma unroll
    for (int j2 = 0; j2 < 4; ++j2) {
      u32x4 pp;
      pp.x = pack2(sT[2 * j2][0], sT[2 * j2][1]);
      pp.y = pack2(sT[2 * j2][2], sT[2 * j2][3]);
      pp.z = pack2(sT[2 * j2 + 1][0], sT[2 * j2 + 1][1]);
      pp.w = pack2(sT[2 * j2 + 1][2], sT[2 * j2 + 1][3]);
      pf[j2] = __builtin_bit_cast(bf16x8, pp);
    }
  }
  f32x4 oT[8];
  u32x2 park[8];
  float ssum = 0.f, ssq = 0.f;
  DMA_WAIT_SYNC();
  RO_DMA_R(X, 0, 0);
  ro_pv(Y, pf, oT, l15, q);
  RO_WAIT_SYNC();
  RO_DMA_R(Y, 1, 0);
  ro_cross(X, xif, qf, oT, l15, q);
  RO_WAIT_SYNC();
  RO_DMA_V(X, 1);
  ro_cross(Y, xib, qf, oT, l15, q);
#pragma unroll
  for (int d = 0; d < 8; ++d) {
#pragma unroll
    for (int r = 0; r < 4; ++r) { float v = oT[d][r]; ssum += v; ssq += v * v; }
    park[d].x = pack2(oT[d][0], oT[d][1]);
    park[d].y = pack2(oT[d][2], oT[d][3]);
  }
  RO_WAIT_SYNC();
  RO_DMA_R(Y, 0, 1);
  ro_pv(X, pf, oT, l15, q);
  RO_WAIT_SYNC();
  RO_DMA_R(X, 1, 1);
  ro_cross(Y, xif, qf, oT, l15, q);
  RO_WAIT_SYNC();
  ro_cross(X, xib, qf, oT, l15, q);
#pragma unroll
  for (int d = 0; d < 8; ++d)
#pragma unroll
    for (int r = 0; r < 4; ++r) { float v = oT[d][r]; ssum += v; ssq += v * v; }
#undef RO_DMA_K
#undef RO_DMA_V
#undef RO_DMA_R
  ssum += __shfl_xor(ssum, 16); ssum += __shfl_xor(ssum, 32);
  ssq += __shfl_xor(ssq, 16); ssq += __shfl_xor(ssq, 32);
  const float mu = ssum * (1.f / 256.f);
  const float var = fmaxf(ssq * (1.f / 256.f) - mu * mu, 0.f);
  const float rs = rsqrtf(var + LN_EPS);
  const int tok = tok0 + i;
  const u16* grow = P.Rg + (size_t)tok * 2048 + h * 256 + q * 4;
  u16* orow = P.ret + (size_t)tok * 2048 + h * 256 + q * 4;
#pragma unroll
  for (int d = 0; d < 8; ++d) {
    {
      u32x2 pvv = park[d];
      uint2 g = *(const uint2*)(grow + d * 16);
      float g0 = bflo(g.x), g1 = bfhi(g.x), g2 = bflo(g.y), g3 = bfhi(g.y);
      uint2 o;
      o.x = pack2((bflo(pvv.x) - mu) * rs * g0 * sigm(g0), (bfhi(pvv.x) - mu) * rs * g1 * sigm(g1));
      o.y = pack2((bflo(pvv.y) - mu) * rs * g2 * sigm(g2), (bfhi(pvv.y) - mu) * rs * g3 * sigm(g3));
      *(uint2*)(orow + d * 16) = o;
    }
    {
      uint2 g = *(const uint2*)(grow + 128 + d * 16);
      float g0 = bflo(g.x), g1 = bfhi(g.x), g2 = bflo(g.y), g3 = bfhi(g.y);
      uint2 o;
      o.x = pack2((oT[d][0] - mu) * rs * g0 * sigm(g0), (oT[d][1] - mu) * rs * g1 * sigm(g1));
      o.y = pack2((oT[d][2] - mu) * rs * g2 * sigm(g2), (oT[d][3] - mu) * rs * g3 * sigm(g3));
      *(uint2*)(orow + 128 + d * 16) = o;
    }
  }
}

__device__ __forceinline__ void phase_att_merge(PREF P, int slab) {
  const int Sshift = slab < 2 ? 12 : 13;
  const int nitems = TS * 8 * 16;
  for (int idx = bid_() * NTHR + tid_(); idx < nitems; idx += gdim_() * NTHR) {
    const int d8 = idx & 15, hs = (idx >> 4) & 7, m = idx >> 7;
    int pg[3];
    float ls[3];
#pragma unroll
    for (int g = 0; g < 3; ++g) {
      pg[g] = posmap(m, Sshift, 2 * g);
      ls[g] = P.lse[((size_t)g * TS + pg[g]) * 8 + hs];
    }
    float mx = fmaxf(ls[0], fmaxf(ls[1], ls[2]));
    float e0 = __expf(ls[0] - mx), e1 = __expf(ls[1] - mx), e2 = __expf(ls[2] - mx);
    float inv = 1.f / (e0 + e1 + e2);
    float wg[3] = {e0 * inv, e1 * inv, e2 * inv};
    float a[8];
#pragma unroll
    for (int e = 0; e < 8; ++e) a[e] = 0.f;
#pragma unroll
    for (int g = 0; g < 3; ++g) {
      uint4 v = *(const uint4*)(P.og + ((size_t)g * TS + pg[g]) * 1024 + hs * 128 + d8 * 8);
      a[0] += wg[g] * bflo(v.x); a[1] += wg[g] * bfhi(v.x);
      a[2] += wg[g] * bflo(v.y); a[3] += wg[g] * bfhi(v.y);
      a[4] += wg[g] * bflo(v.z); a[5] += wg[g] * bfhi(v.z);
      a[6] += wg[g] * bflo(v.w); a[7] += wg[g] * bfhi(v.w);
    }
    uint4 o;
    o.x = pack2(a[0], a[1]); o.y = pack2(a[2], a[3]); o.z = pack2(a[4], a[5]); o.w = pack2(a[6], a[7]);
    *(uint4*)(P.att + (size_t)m * 1024 + hs * 128 + d8 * 8) = o;
  }
}

__device__ __forceinline__ void phase_gemm2(PREF P, char* smem) {
  const int lane = tid_() & 63, wid = tid_() >> 6, wm = wid >> 1, wn = wid & 1, l15 = lane & 15, q = lane >> 4;
  for (int t = bid_(); t < 64 * 16; t += gdim_()) {
    int mt, nt;
    tile_map(t, 2, mt, nt);
    const int m0 = mt * 128, n0 = nt * 128;
    f32x4 acc[4][4];
    gemm_core(P.ret, 2048, P.WretT, 2048, 2048, m0, n0, 13, 0, smem, acc);
#pragma unroll
    for (int i = 0; i < 4; ++i)
#pragma unroll
      for (int j = 0; j < 4; ++j) {
        const int row = m0 + wm * 64 + i * 16 + l15, col = n0 + (j & 1) * 16 + wn * 32 + (j >> 1) * 64 + q * 4;
        const unsigned g = *(const unsigned*)((const u8*)P.GA + (size_t)row * 2048 + col);
        f32x4 v;
        v[0] = (float)(g & 255u) * (1.f / 255.f) * acc[i][j][0]; v[1] = (float)((g >> 8) & 255u) * (1.f / 255.f) * acc[i][j][1];
        v[2] = (float)((g >> 16) & 255u) * (1.f / 255.f) * acc[i][j][2]; v[3] = (float)(g >> 24) * (1.f / 255.f) * acc[i][j][3];
        store_nat(P.merged, 2048, row, col, v);
      }
    gemm_core(P.att, 1024, P.WattT, 1024, 1024, m0, n0, 13, 0, smem, acc);
#pragma unroll
    for (int i = 0; i < 4; ++i)
#pragma unroll
      for (int j = 0; j < 4; ++j) {
        const int row = m0 + wm * 64 + i * 16 + l15, col = n0 + (j & 1) * 16 + wn * 32 + (j >> 1) * 64 + q * 4;
        const unsigned g = *(const unsigned*)((const u8*)P.GB + (size_t)row * 2048 + col);
        uint2 pr = *(const uint2*)(P.merged + (size_t)row * 2048 + col);
        f32x4 v;
        v[0] = bflo(pr.x) + (float)(g & 255u) * (1.f / 255.f) * acc[i][j][0];
        v[1] = bfhi(pr.x) + (float)((g >> 8) & 255u) * (1.f / 255.f) * acc[i][j][1];
        v[2] = bflo(pr.y) + (float)((g >> 16) & 255u) * (1.f / 255.f) * acc[i][j][2];
        v[3] = bfhi(pr.y) + (float)(g >> 24) * (1.f / 255.f) * acc[i][j][3];
        acc[i][j] = v;
      }
    stage_tile_bf16(smem, acc, P.merged, 2048, m0, n0);
  }
}

__device__ __forceinline__ void phase_gemm3(PREF P, int slab, char* smem) {
  const int lane = tid_() & 63, wid = tid_() >> 6, wm = wid >> 1, wn = wid & 1, l15 = lane & 15, q = lane >> 4;
  const float* xs = x_slab(P, slab);
  for (int t = bid_(); t < 64 * 16; t += gdim_()) {
    int mt, nt;
    tile_map(t, 2, mt, nt);
    const int m0 = mt * 128, n0 = nt * 128;
    f32x4 acc[4][4];
    gemm_core(P.merged, 2048, P.WoutT, 2048, 2048, m0, n0, 13, 0, smem, acc);
#pragma unroll
    for (int i = 0; i < 4; ++i)
#pragma unroll
      for (int j = 0; j < 4; ++j) {
        const int row = m0 + wm * 64 + i * 16 + l15, col = n0 + (j & 1) * 16 + wn * 32 + (j >> 1) * 64 + q * 4;
        float4 xv = *(const float4*)(xs + (size_t)row * 2048 + col);
        f32x4 o;
        o[0] = DN_ALPHA * xv.x + acc[i][j][0]; o[1] = DN_ALPHA * xv.y + acc[i][j][1];
        o[2] = DN_ALPHA * xv.z + acc[i][j][2]; o[3] = DN_ALPHA * xv.w + acc[i][j][3];
        acc[i][j] = o;
      }
    stage_tile_bf16(smem, acc, (u16*)P.y, 2048, m0, n0);
  }
}

__device__ __forceinline__ void phase_ln1(PREF P) {
  const int lane = tid_() & 63, wid = tid_() >> 6;
  for (int t = bid_() * 4 + wid; t < TS; t += gdim_() * 4) {
    const u16* yr = (const u16*)P.y + (size_t)t * 2048;
    float v[32];
#pragma unroll
    for (int u = 0; u < 4; ++u) {
      u32x4 a = *(const u32x4*)(yr + u * 512 + lane * 8);
      v[u * 8 + 0] = bflo(a.x); v[u * 8 + 1] = bfhi(a.x); v[u * 8 + 2] = bflo(a.y); v[u * 8 + 3] = bfhi(a.y);
      v[u * 8 + 4] = bflo(a.z); v[u * 8 + 5] = bfhi(a.z); v[u * 8 + 6] = bflo(a.w); v[u * 8 + 7] = bfhi(a.w);
    }
    float s = 0.f;
#pragma unroll
    for (int e = 0; e < 32; ++e) s += v[e];
    const float mu = wsum(s) * (1.f / 2048.f);
    float vs = 0.f;
#pragma unroll
    for (int e = 0; e < 32; ++e) { float d = v[e] - mu; vs += d * d; }
    const float rs = rsqrtf(wsum(vs) * (1.f / 2048.f) + LN_EPS);
#pragma unroll
    for (int u = 0; u < 4; ++u) {
      const int c = u * 512 + lane * 8;
      float4 g0 = *(const float4*)(P.ln1_g + c), g1 = *(const float4*)(P.ln1_g + c + 4);
      float4 b0 = *(const float4*)(P.ln1_b + c), b1 = *(const float4*)(P.ln1_b + c + 4);
      uint4 o;
      o.x = pack2((v[u * 8 + 0] - mu) * rs * g0.x + b0.x, (v[u * 8 + 1] - mu) * rs * g0.y + b0.y);
      o.y = pack2((v[u * 8 + 2] - mu) * rs * g0.z + b0.z, (v[u * 8 + 3] - mu) * rs * g0.w + b0.w);
      o.z = pack2((v[u * 8 + 4] - mu) * rs * g1.x + b1.x, (v[u * 8 + 5] - mu) * rs * g1.y + b1.y);
      o.w = pack2((v[u * 8 + 6] - mu) * rs * g1.z + b1.z, (v[u * 8 + 7] - mu) * rs * g1.w + b1.w);
      *(uint4*)(P.hb + (size_t)t * 2048 + c) = o;
    }
    float am = 0.f;
#pragma unroll
    for (int u = 0; u < 4; ++u) {
      const int c = u * 512 + lane * 8;
      float4 g0 = *(const float4*)(P.ln1_g + c), g1 = *(const float4*)(P.ln1_g + c + 4);
      float4 b0 = *(const float4*)(P.ln1_b + c), b1 = *(const float4*)(P.ln1_b + c + 4);
      v[u * 8 + 0] = (v[u * 8 + 0] - mu) * rs * g0.x + b0.x; v[u * 8 + 1] = (v[u * 8 + 1] - mu) * rs * g0.y + b0.y;
      v[u * 8 + 2] = (v[u * 8 + 2] - mu) * rs * g0.z + b0.z; v[u * 8 + 3] = (v[u * 8 + 3] - mu) * rs * g0.w + b0.w;
      v[u * 8 + 4] = (v[u * 8 + 4] - mu) * rs * g1.x + b1.x; v[u * 8 + 5] = (v[u * 8 + 5] - mu) * rs * g1.y + b1.y;
      v[u * 8 + 6] = (v[u * 8 + 6] - mu) * rs * g1.z + b1.z; v[u * 8 + 7] = (v[u * 8 + 7] - mu) * rs * g1.w + b1.w;
    }
#pragma unroll
    for (int e = 0; e < 32; ++e) am = fmaxf(am, fabsf(v[e]));
    am = wmax(am);
    const float sc = am > 0.f ? am * (1.f / 127.f) : 1.f;
    const float inv = 1.f / sc;
#pragma unroll
    for (int u = 0; u < 4; ++u) {
      u32x2 o;
      o.x = q4(v[u * 8 + 0], v[u * 8 + 1], v[u * 8 + 2], v[u * 8 + 3], inv, 0);
      o.y = q4(v[u * 8 + 4], v[u * 8 + 5], v[u * 8 + 6], v[u * 8 + 7], inv, 0);
      *(u32x2*)(P.h8 + (size_t)t * 2048 + u * 512 + lane * 8) = o;
    }
    if (lane == 0) P.sh[t] = sc;
  }
}

__device__ __forceinline__ void phase_gemm45(PREF P, char* smem, int which) {
  const int lane = tid_() & 63, wid = tid_() >> 6, wm = wid >> 1, wn = wid & 1, l15 = lane & 15, q = lane >> 4;
  for (int t = bid_(); t < 64 * 16; t += gdim_()) {
    int mt, nt;
    tile_map(t, 2, mt, nt);
    const int m0 = mt * 128, n0 = nt * 128;
    f32x4 acc[4][4];
    if (!which) {
      i32x4 iacc[4][4];
      gemm_core_i8(P.h8, 2048, P.Wq8, 2048, 2048, m0, n0, 13, 0, smem, iacc);
#pragma unroll
      for (int i = 0; i < 4; ++i) {
        const int row = m0 + wm * 64 + i * 16 + l15;
        const float shr = P.sh[row];
#pragma unroll
        for (int j = 0; j < 4; ++j) {
          const int col = n0 + (j & 1) * 16 + wn * 32 + (j >> 1) * 64 + q * 4;
          const float4 swc = *(const float4*)(P.swq + col);
          f32x4 v;
          v[0] = (float)iacc[i][j][0] * shr * swc.x; v[1] = (float)iacc[i][j][1] * shr * swc.y;
          v[2] = (float)iacc[i][j][2] * shr * swc.z; v[3] = (float)iacc[i][j][3] * shr * swc.w;
          acc[i][j] = v;
        }
      }
      stage_tile_bf16(smem, acc, P.qb, 2048, m0, n0);
    } else {
      unsigned part[4][4][2];
      {
        i32x4 iacc[4][4];
        gemm_core_i8(P.h8, 2048, P.Wpg8, 2048, 2048, m0, n0, 13, 0, smem, iacc);
#pragma unroll
        for (int i = 0; i < 4; ++i) {
          const int row = m0 + wm * 64 + i * 16 + l15;
          const float shr = P.sh[row];
#pragma unroll
          for (int j = 0; j < 4; ++j) {
            const int col = n0 + (j & 1) * 16 + wn * 32 + (j >> 1) * 64 + q * 4;
            const float4 swc = *(const float4*)(P.swpg + col);
            part[i][j][0] = pack2(sigm((float)iacc[i][j][0] * shr * swc.x), sigm((float)iacc[i][j][1] * shr * swc.y));
            part[i][j][1] = pack2(sigm((float)iacc[i][j][2] * shr * swc.z), sigm((float)iacc[i][j][3] * shr * swc.w));
          }
        }
      }
      gemm_core(P.pb, 256, P.WpeT, 256, 256, m0, n0, 13, 0, smem, acc);
#pragma unroll
      for (int i = 0; i < 4; ++i)
#pragma unroll
        for (int j = 0; j < 4; ++j) {
          const int row = m0 + wm * 64 + i * 16 + l15, col = n0 + (j & 1) * 16 + wn * 32 + (j >> 1) * 64 + q * 4;
          f32x4 v;
          v[0] = bflo(part[i][j][0]) * acc[i][j][0]; v[1] = bfhi(part[i][j][0]) * acc[i][j][1];
          v[2] = bflo(part[i][j][1]) * acc[i][j][2]; v[3] = bfhi(part[i][j][1]) * acc[i][j][3];
          acc[i][j] = v;
        }
      stage_tile_bf16(smem, acc, P.peb, 2048, m0, n0);
    }
  }
}

DEV void ce_insert(float (&top)[16], float x) {
#pragma unroll
  for (int p = 0; p < 16; ++p) {
    float hi = fmaxf(top[p], x), lo = fminf(top[p], x);
    top[p] = hi; x = lo;
  }
}

__device__ __forceinline__ void peer_topk_item(PREF P, int w, char* smem) {
  float* Ls = (float*)smem;
  float* Ll = (float*)(smem + 2 * 64 * 129 * 4);
  const int tid = tid_(), lane = tid & 63, wid = tid >> 6, l15 = lane & 15, q = lane >> 4;
  const int tb = w >> 3, h = w & 7, t0 = tb * 64;
  __syncthreads();
  {
    const int c = wid >> 1, th = wid & 1;
    f32x4 acc[8][2];
#pragma unroll
    for (int a = 0; a < 8; ++a) { acc[a][0] = f32x4{0.f, 0.f, 0.f, 0.f}; acc[a][1] = f32x4{0.f, 0.f, 0.f, 0.f}; }
#pragma unroll
    for (int kd = 0; kd < 4; ++kd) {
      bf16x8 qf[2];
#pragma unroll
      for (int tt = 0; tt < 2; ++tt)
        qf[tt] = *(const bf16x8*)(P.qb + (size_t)(t0 + th * 32 + tt * 16 + l15) * 2048 + h * 256 + c * 128 + kd * 32 + q * 8);
#pragma unroll
      for (int kt = 0; kt < 8; ++kt) {
        bf16x8 kf = *(const bf16x8*)(P.keysb + (size_t)((h * 2 + c) * 128 + kt * 16 + l15) * 128 + kd * 32 + q * 8);
        acc[kt][0] = MFMA(kf, qf[0], acc[kt][0]);
        acc[kt][1] = MFMA(kf, qf[1], acc[kt][1]);
      }
    }
#pragma unroll
    for (int kt = 0; kt < 8; ++kt)
#pragma unroll
      for (int tt = 0; tt < 2; ++tt)
#pragma unroll
        for (int r = 0; r < 4; ++r) Ls[(c * 64 + th * 32 + tt * 16 + l15) * 129 + kt * 16 + q * 4 + r] = acc[kt][tt][r];
  }
  __syncthreads();
  {
    const int row = tid & 127, half = tid >> 7;
    float top[16];
#pragma unroll
    for (int k = 0; k < 16; ++k) top[k] = -3.0e38f;
    const float* src = Ls + row * 129 + half * 64;
#pragma unroll 4
    for (int k = 0; k < 64; ++k) {
      float x = __uint_as_float((__float_as_uint(src[k]) & ~127u) | (unsigned)(half * 64 + k));
      ce_insert(top, x);
    }
    if (half == 1) {
#pragma unroll
      for (int k = 0; k < 16; ++k) Ll[row * 17 + k] = top[k];
    }
    __syncthreads();
    if (half == 0) {
#pragma unroll
      for (int k = 0; k < 16; ++k) ce_insert(top, Ll[row * 17 + k]);
    }
    __syncthreads();
    if (half == 0) {
#pragma unroll
      for (int k = 0; k < 16; ++k) Ll[row * 17 + k] = top[k];
    }
    __syncthreads();
  }
  if (tid < 64) {
    const int t = tid;
    float a[16], b[16];
#pragma unroll
    for (int k = 0; k < 16; ++k) {
      a[k] = __uint_as_float(__float_as_uint(Ll[t * 17 + k]) & ~127u);
      b[k] = __uint_as_float(__float_as_uint(Ll[(64 + t) * 17 + k]) & ~127u);
    }
    float top[16];
#pragma unroll
    for (int k = 0; k < 16; ++k) top[k] = -3.0e38f;
#pragma unroll
    for (int i = 0; i < 16; ++i)
#pragma unroll
      for (int j = 0; j < 16; ++j)
        if ((i + 1) * (j + 1) <= 16) {
          float s = a[i] + b[j];
          s = __uint_as_float((__float_as_uint(s) & ~255u) | (unsigned)(i * 16 + j));
          ce_insert(top, s);
        }
    const float best0 = __uint_as_float(__float_as_uint(top[0]) & ~255u);
    float ev[16], sum = 0.f;
#pragma unroll
    for (int k = 0; k < 16; ++k) {
      float bk = __uint_as_float(__float_as_uint(top[k]) & ~255u);
      ev[k] = __expf(bk - best0);
      sum += ev[k];
    }
    const float inv = 1.f / sum;
#pragma unroll
    for (int k = 0; k < 16; ++k) {
      unsigned code = __float_as_uint(top[k]) & 255u;
      int ia = __float_as_uint(Ll[t * 17 + (code >> 4)]) & 127u;
      int ib = __float_as_uint(Ll[(64 + t) * 17 + (code & 15u)]) & 127u;
      P.eidx[(size_t)(t0 + t) * 128 + h * 16 + k] = ia * 128 + ib;
      P.gw[(size_t)(t0 + t) * 128 + h * 16 + k] = ev[k] * inv;
    }
  }
}

DEV float gelu_exact(float x) { return 0.5f * x * (1.f + erff(x * 0.70710678118654752f)); }
DEV void axpy_ub(float* acc, float c, unsigned w) {
  acc[0] += c * (float)(w & 0xffu); acc[1] += c * (float)((w >> 8) & 0xffu);
  acc[2] += c * (float)((w >> 16) & 0xffu); acc[3] += c * (float)(w >> 24);
}
DEV void ld16bf(const u16* p, float* o) {
  u32x4 a = *(const u32x4*)p, b = *(const u32x4*)(p + 8);
  o[0] = bflo(a.x); o[1] = bfhi(a.x); o[2] = bflo(a.y); o[3] = bfhi(a.y);
  o[4] = bflo(a.z); o[5] = bfhi(a.z); o[6] = bflo(a.w); o[7] = bfhi(a.w);
  o[8] = bflo(b.x); o[9] = bfhi(b.x); o[10] = bflo(b.y); o[11] = bfhi(b.y);
  o[12] = bflo(b.z); o[13] = bfhi(b.z); o[14] = bflo(b.w); o[15] = bfhi(b.w);
}

__device__ __forceinline__ void phase_peer_gather(PREF P, int slab, int tbeg, int tend) {
  const int lane = tid_() & 63, wid = tid_() >> 6;
  float* outs = P.out + (size_t)slab * TS * DM;
  typedef const __attribute__((address_space(1))) unsigned char* gbytes_t;
  gbytes_t U8 = (gbytes_t)P.Ub;
  gbytes_t V8 = (gbytes_t)P.Vb;
  for (int t = tbeg + bid_() * 4 + wid; t < tend; t += gdim_() * 4) {
    const u16* hrow = P.hb + (size_t)t * 2048 + lane * 16;
    int xq[8];
    float sh;
    {
      float hv[32];
      ld16bf(hrow, hv);
      ld16bf(hrow + 1024, hv + 16);
      float am = 0.f;
#pragma unroll
      for (int e = 0; e < 32; ++e) am = fmaxf(am, fabsf(hv[e]));
      am = wmax(am);
      sh = am > 0.f ? am * (1.f / 127.f) : 1.f;
      const float inv = 1.f / sh;
#pragma unroll
      for (int w = 0; w < 8; ++w) xq[w] = (int)q4(hv[w * 4], hv[w * 4 + 1], hv[w * 4 + 2], hv[w * 4 + 3], inv, 0);
    }
    float acc[32];
#pragma unroll
    for (int e = 0; e < 32; ++e) acc[e] = 0.f;
    float csum = 0.f;
#pragma unroll 1
    for (int half = 0; half < 2; ++half) {
      const int ev = P.eidx[(size_t)t * 128 + half * 64 + lane];
      const int gv = __float_as_int(P.gw[(size_t)t * 128 + half * 64 + lane]);
      const int suv = __float_as_int(P.su[ev]);
      const int svv = __float_as_int(P.sv[ev]);
#pragma unroll 1
      for (int e = 0; e < 64; e += 4) {
        u32x4 ua[4][2], va[4][2];
        float cg[4], csu[4], csv[4];
#pragma unroll
        for (int k = 0; k < 4; ++k) {
          const int ix = __builtin_amdgcn_readlane(ev, e + k);
          cg[k] = __int_as_float(__builtin_amdgcn_readlane(gv, e + k));
          csu[k] = __int_as_float(__builtin_amdgcn_readlane(suv, e + k));
          csv[k] = __int_as_float(__builtin_amdgcn_readlane(svv, e + k));
          typedef const __attribute__((address_space(1))) u32x4* gvec_t;
          gbytes_t up = U8 + (size_t)ix * 2048 + lane * 16;
          gbytes_t vp = V8 + (size_t)ix * 2048 + lane * 16;
          ua[k][0] = *(gvec_t)up; ua[k][1] = *(gvec_t)(up + 1024);
          va[k][0] = *(gvec_t)vp; va[k][1] = *(gvec_t)(vp + 1024);
        }
        int id[4];
#pragma unroll
        for (int k = 0; k < 4; ++k) {
          int d = 0;
          d = __builtin_amdgcn_sdot4((int)ua[k][0].x, xq[0], d, false); d = __builtin_amdgcn_sdot4((int)ua[k][0].y, xq[1], d, false);
          d = __builtin_amdgcn_sdot4((int)ua[k][0].z, xq[2], d, false); d = __builtin_amdgcn_sdot4((int)ua[k][0].w, xq[3], d, false);
          d = __builtin_amdgcn_sdot4((int)ua[k][1].x, xq[4], d, false); d = __builtin_amdgcn_sdot4((int)ua[k][1].y, xq[5], d, false);
          d = __builtin_amdgcn_sdot4((int)ua[k][1].z, xq[6], d, false); d = __builtin_amdgcn_sdot4((int)ua[k][1].w, xq[7], d, false);
          id[k] = d;
        }
#pragma unroll
        for (int k = 0; k < 4; ++k) id[k] = wsum_i(id[k]);
#pragma unroll
        for (int k = 0; k < 4; ++k) {
          const float d = (float)id[k] * csu[k] * sh;
          const float c = cg[k] * gelu_exact(d) * csv[k];
          csum += c;
          axpy_ub(acc + 0, c, va[k][0].x);  axpy_ub(acc + 4, c, va[k][0].y);
          axpy_ub(acc + 8, c, va[k][0].z);  axpy_ub(acc + 12, c, va[k][0].w);
          axpy_ub(acc + 16, c, va[k][1].x); axpy_ub(acc + 20, c, va[k][1].y);
          axpy_ub(acc + 24, c, va[k][1].z); axpy_ub(acc + 28, c, va[k][1].w);
        }
      }
    }
    {
      const float corr = 128.f * csum;
      float hv[16], pv[16];
#pragma unroll
      for (int hf = 0; hf < 2; ++hf) {
        ld16bf(hrow + hf * 1024, hv);
        ld16bf(P.peb + (size_t)t * 2048 + lane * 16 + hf * 1024, pv);
#pragma unroll
        for (int e = 0; e < 16; ++e) acc[hf * 16 + e] = acc[hf * 16 + e] - corr + DN_ALPHA * hv[e] + pv[e];
      }
    }
    float s = 0.f;
#pragma unroll
    for (int e = 0; e < 32; ++e) s += acc[e];
    const float mu = wsum(s) * (1.f / 2048.f);
    float vs = 0.f;
#pragma unroll
    for (int e = 0; e < 32; ++e) { float d = acc[e] - mu; vs += d * d; }
    const float rs = rsqrtf(wsum(vs) * (1.f / 2048.f) + LN_EPS);
    float* orow = outs + (size_t)t * 2048;
#pragma unroll
    for (int hf = 0; hf < 2; ++hf)
#pragma unroll
      for (int c4 = 0; c4 < 4; ++c4) {
        const int c = hf * 1024 + lane * 16 + c4 * 4;
        float4 g = *(const float4*)(P.ln2_g + c), b = *(const float4*)(P.ln2_b + c);
        float4 o;
        o.x = (acc[hf * 16 + c4 * 4 + 0] - mu) * rs * g.x + b.x;
        o.y = (acc[hf * 16 + c4 * 4 + 1] - mu) * rs * g.y + b.y;
        o.z = (acc[hf * 16 + c4 * 4 + 2] - mu) * rs * g.z + b.z;
        o.w = (acc[hf * 16 + c4 * 4 + 3] - mu) * rs * g.w + b.w;
        *(float4*)(orow + c) = o;
      }
  }
}

__device__ void build_bias_table(PREF P) {
  const int gtid = bid_() * NTHR + tid_();
  if (gtid < 24 * 129) {
    const int o = gtid % 129, gh = gtid / 129, gi = gh >> 3;
    const int rel = (o - 64) << (2 * gi);
    int ret = rel > 0 ? 16 : 0;
    int n = rel < 0 ? -rel : rel;
    int bucket;
    if (n < 8) bucket = n;
    else {
      int large = 8 + (int)(logf((float)n / 8.f) / 4.852030263919617f * 8.f);
      bucket = large < 15 ? large : 15;
    }
    P.biasT[gtid] = P.rel_bias[(ret + bucket) * 24 + gh];
  }
}

#define XB_TMO      128
#define XB_XCNT(j)  (256  + 64 * (j))
#define XB_XSUB(j)  (1280 + 64 * (j))
#define XB_XGEN(j)  (2304 + 64 * (j))
#define XB_TOP      3328
#define XB_TOPGEN   3392
#define XCD_BAR_WORDS 3456
#define CU_CENSUS_BASE 3584
#define BAR_TOTAL_WORDS (3584 + 4096)
#define XB_SPIN_CAP (1u << 20)
#define LAS __attribute__((address_space(3)))
DEV unsigned xb_ld(unsigned* p) { return __hip_atomic_load(p, __ATOMIC_RELAXED, __HIP_MEMORY_SCOPE_AGENT); }
DEV unsigned xb_add(unsigned* p, unsigned v) { return __hip_atomic_fetch_add(p, v, __ATOMIC_RELAXED, __HIP_MEMORY_SCOPE_AGENT); }
DEV unsigned xb_xcc_id() { return (unsigned)__builtin_amdgcn_s_getreg((3 << 11) | 20) & 0xFu; }
#define XB_SPIN(cond, bar) do { unsigned _sp = 0; while (cond) { __builtin_amdgcn_s_sleep(1); \
    if ((++_sp & 255u) == 0u) { if (xb_ld(&(bar)[XB_TMO])) break; if (_sp > XB_SPIN_CAP) { atomicAdd(&(bar)[XB_TMO], 1u); break; } } } } while (0)
struct XcdBarrier { unsigned* bar; unsigned x; volatile LAS unsigned* st; };
DEV XcdBarrier xcd_barrier_post(unsigned* bar, volatile LAS unsigned* st) {
  XcdBarrier b; b.bar = bar; b.x = xb_xcc_id(); b.st = st;
  if (threadIdx.x == 0) (void)xb_add(&bar[XB_XCNT(b.x)], 1u);
  return b;
}
DEV void xcd_barrier_complete(unsigned* bar, unsigned x, unsigned& nloc, unsigned& nx) {
  const unsigned G = gridDim.x * gridDim.y * gridDim.z;
  unsigned sum, cnt, mine, sp = 0u;
  for (;;) {
    sum = 0u; cnt = 0u; mine = 0u;
#pragma unroll
    for (unsigned j = 0; j < 16; ++j) { const unsigned c = xb_ld(&bar[XB_XCNT(j)]); sum += c; cnt += (c > 0u) ? 1u : 0u; mine = (j == x) ? c : mine; }
    if (sum == G) break;
    __builtin_amdgcn_s_sleep(1);
    if ((++sp & 255u) == 0u) { if (xb_ld(&bar[XB_TMO])) break; if (sp > XB_SPIN_CAP) { atomicAdd(&bar[XB_TMO], 1u); break; } }
  }
  nloc = mine > 0u ? mine : 1u; nx = cnt > 0u ? cnt : 1u;
}
DEV void xcd_barrier(const XcdBarrier& b) {
  asm volatile("s_waitcnt vmcnt(0)" ::: "memory");
  __syncthreads();
  if (threadIdx.x == 0) {
    unsigned* bar = b.bar;
    __builtin_amdgcn_s_waitcnt(0);
    unsigned nloc = b.st[0], nx = b.st[1];
    if (nloc == 0u) { xcd_barrier_complete(bar, b.x, nloc, nx); b.st[0] = nloc; b.st[1] = nx; }
    const unsigned old = xb_add(&bar[XB_XSUB(b.x)], 1u);
    const unsigned gen = old / nloc;
    if (old + 1u == (gen + 1u) * nloc) {
      __builtin_amdgcn_fence(__ATOMIC_RELEASE, "agent");
      asm volatile("s_waitcnt vmcnt(0)" ::: "memory");
      const unsigned og = xb_add(&bar[XB_TOP], 1u);
      const unsigned tg = og / nx;
      if (og + 1u == (tg + 1u) * nx) xb_add(&bar[XB_TOPGEN], 1u);
      else XB_SPIN(xb_ld(&bar[XB_TOPGEN]) == tg, bar);
      __builtin_amdgcn_fence(__ATOMIC_ACQUIRE, "agent");
      xb_add(&bar[XB_XGEN(b.x)], 1u);
      asm volatile("s_waitcnt vmcnt(0)" ::: "memory");
    } else {
      XB_SPIN(xb_ld(&bar[XB_XGEN(b.x)]) == gen, bar);
      __builtin_amdgcn_fence(__ATOMIC_ACQUIRE, "agent");
      asm volatile("s_waitcnt vmcnt(0)" ::: "memory");
    }
  }
  __syncthreads();
}

#ifndef REPA
#define REPA 1
#endif
#ifndef REPB
#define REPB 1
#endif
#ifndef REPD
#define REPD 1
#endif
#ifndef REPE
#define REPE 1
#endif
#ifndef REPI
#define REPI 1
#endif
#ifndef REPJ
#define REPJ 1
#endif
#ifndef REPS
#define REPS 1
#endif
__global__ void __launch_bounds__(NTHR, 2) fwd_megakernel(Params Pk) {
  __shared__ __attribute__((aligned(16))) char smem[SMEM_BYTES];
  __shared__ Params sP;
  cg::grid_group grid = cg::this_grid();
  {
    const unsigned* srcw = (const unsigned*)&Pk;
    unsigned* dstw = (unsigned*)&sP;
    for (int i = tid_(); i < (int)(sizeof(Params) / 4); i += NTHR) dstw[i] = srcw[i];
  }
  __shared__ uint4 xb_words;
  __shared__ unsigned cu_slot_s;
  if (threadIdx.x == 0) xb_words = make_uint4(0u, 0u, 0u, 0u);
  __syncthreads();
  LParams* lp = (LParams*)&sP;
#define P (*launderP(lp))
  const XcdBarrier xb = xcd_barrier_post(Pk.bar, (volatile LAS unsigned*)&xb_words);
  if (threadIdx.x == 0) {
    const unsigned hwid = (unsigned)__builtin_amdgcn_s_getreg((31 << 11) | 4);
    const unsigned key = (xb.x & 15u) * 256u + ((hwid >> 8) & 127u);
    cu_slot_s = xb_add(&Pk.bar[CU_CENSUS_BASE + key], 1u);
  }
  __syncthreads();
  const int cu_slot = (int)(blockIdx.x & 1u);
#define GSYNC() xcd_barrier(xb)

  transpose_convert(P.w_in, 2048, 19456, P.WinTtmp, smem);
  transpose_convert(P.w_ret_o, 2048, 2048, P.WretT, smem);
  transpose_convert(P.w_att_o, 1024, 2048, P.WattT, smem);
  transpose_convert(P.w_out, 2048, 2048, P.WoutT, smem);
  transpose_convert(P.peer_wq, 2048, 2048, P.WqTtmp, smem);
  transpose_convert(P.w_pg, 2048, 2048, P.WpgTtmp, smem);
  transpose_convert(P.w_pe, 256, 2048, P.WpeT, smem);
  convert_bf16(P.peer_keys, P.keysb, 262144 / 8);
  quant_rows_f32(P.peer_u, (unsigned char*)P.Ub, P.su, 16384, 0);
  quant_rows_f32(P.peer_v, (unsigned char*)P.Vb, P.sv, 16384, 128);
  quant_rows_f32(x_slab(P, 0), P.xq8, P.sx, TS, 0);
  build_bias_table(P);
  grid.sync();
  quant_rows_bf16(P.WinTtmp, P.Win8, P.sw, 19456);
  quant_rows_bf16(P.WpgTtmp, P.Wpg8, P.swpg, 2048);
  quant_rows_bf16(P.WqTtmp, P.Wq8, P.swq, 2048);
  GSYNC();

#pragma unroll 1
  for (int slab = -1; slab < 4; ++slab) {
    if (slab >= 0) {
      const int Sshift = slab < 2 ? 12 : 13;
      u16* ST = (u16*)(P.out + (size_t)slab * TS * DM);
#pragma unroll 1
      for (int part = 0; part < 2; ++part) {
        if (part == cu_slot) {
          for (int w = bid_(); w < 1024 + 3072; w += gdim_()) {
            if (w < 1024) ret_kv_item(P, w, ST, smem);
            else attn_item(P, w - 1024, Sshift, smem);
          }
        } else if (slab >= 1) {
          phase_peer_gather(P, slab - 1, JSPLIT, TS);
        }
      }
      GSYNC();
      phase_scan(P, slab, ST);
      if (slab + 1 < 4) quant_rows_f32(x_slab(P, slab + 1), P.xq8, P.sx, TS, 0);
      convert_bf16(p_slab(P, slab), P.pb, (size_t)TS * 256 / 8);
      phase_att_merge(P, slab);
      GSYNC();
      for (int w = bid_(); w < 1024; w += gdim_()) ret_out_item(P, w, ST, smem);
      GSYNC();
      phase_gemm2(P, smem);
      GSYNC();
      phase_gemm3(P, slab, smem);
      GSYNC();
      phase_ln1(P);
      GSYNC();
      phase_gemm45(P, smem, 0);
      GSYNC();
#pragma unroll 1
      for (int part = 0; part < 2; ++part) {
        if (part == cu_slot) phase_gemm45(P, smem, 1);
        else for (int w = bid_(); w < 1024; w += gdim_()) peer_topk_item(P, w, smem);
      }
      GSYNC();
    }
#pragma unroll 1
    for (int part = 0; part < 2; ++part) {
      if (part == cu_slot) { if (slab + 1 < 4) phase_gemm1(P, slab + 1, smem); }
      else { if (slab >= 0) phase_peer_gather(P, slab, 0, slab + 1 < 4 ? JSPLIT : TS); }
    }
    GSYNC();
  }
}

#undef P
#undef GSYNC
extern "C" void kernel_launch(void* const* d_in, const int* in_sizes, int n_in, void* d_out, int out_size, void* d_ws,
                              size_t ws_size, hipStream_t stream) {
  Params P;
  std::memset((void*)&P, 0, sizeof(P));
  P.x_prompt = (const float*)d_in[0];  P.x_sample = (const float*)d_in[1];
  P.p_prompt = (const float*)d_in[2];  P.p_sample = (const float*)d_in[3];
  P.w_in = (const float*)d_in[4];      P.decay_logit = (const float*)d_in[5];
  P.w_ret_o = (const float*)d_in[6];   P.w_att_o = (const float*)d_in[7];
  P.w_out = (const float*)d_in[8];     P.rel_bias = (const float*)d_in[9];
  P.ln1_g = (const float*)d_in[10];    P.ln1_b = (const float*)d_in[11];
  P.peer_wq = (const float*)d_in[12];  P.peer_keys = (const float*)d_in[13];
  P.peer_u = (const float*)d_in[14];   P.peer_v = (const float*)d_in[15];
  P.w_pe = (const float*)d_in[16];     P.w_pg = (const float*)d_in[17];
  P.ln2_g = (const float*)d_in[18];    P.ln2_b = (const float*)d_in[19];
  P.out = (float*)d_out;

  char* base = (char*)d_ws;
  size_t off = 0;
  auto take = [&](size_t bytes) { char* p = base + off; off += (bytes + 255) & ~(size_t)255; return p; };
  P.Win8 = (u8*)take((size_t)19456 * 2048);
  P.sw = (float*)take((size_t)19456 * 4);
  P.WretT = (u16*)take((size_t)2048 * 2048 * 2);
  P.WattT = (u16*)take((size_t)2048 * 1024 * 2);
  P.WoutT = (u16*)take((size_t)2048 * 2048 * 2);
  P.Wq8 = (u8*)take((size_t)2048 * 2048);
  P.swq = (float*)take((size_t)2048 * 4);
  P.Wpg8 = (u8*)take((size_t)2048 * 2048);
  P.swpg = (float*)take((size_t)2048 * 4);
  P.WpeT = (u16*)take((size_t)2048 * 256 * 2);
  P.keysb = (u16*)take((size_t)262144 * 2);
  P.Ub = (u16*)take((size_t)16384 * 2048);
  P.Vb = (u16*)take((size_t)16384 * 2048);
  P.su = (float*)take((size_t)16384 * 4);
  P.sv = (float*)take((size_t)16384 * 4);
  P.xq8 = (u8*)take((size_t)TS * 2048);
  P.sx = (float*)take((size_t)TS * 4);
  P.h8 = (u8*)take((size_t)TS * 2048);
  P.sh = (float*)take((size_t)TS * 4);
  P.pb = (u16*)take((size_t)TS * 256 * 2);
  P.Qr = (u16*)take((size_t)TS * 1024 * 2);
  P.Kr = (u16*)take((size_t)TS * 1024 * 2);
  P.KrT = (u16*)take((size_t)TS * 1024 * 2);
  P.VrT = (u16*)take((size_t)TS * 2048 * 2);
  P.Rg = (u16*)take((size_t)TS * 2048 * 2);
  P.AQ = (u16*)take((size_t)TS * 3072 * 2);
  P.AK = (u16*)take((size_t)TS * 3072 * 2);
  P.AVT = (u16*)take((size_t)TS * 3072 * 2);
  P.GA = (u16*)take((size_t)TS * 2048 * 2);
  P.GB = (u16*)take((size_t)TS * 2048 * 2);
  P.og = (u16*)take((size_t)3 * TS * 1024 * 2);
  P.lse = (float*)take((size_t)3 * TS * 8 * 4);
  P.ret = (u16*)take((size_t)TS * 2048 * 2);
  P.att = (u16*)take((size_t)TS * 1024 * 2);
  P.eidx = (int*)take((size_t)TS * 128 * 4);
  P.gw = (float*)take((size_t)TS * 128 * 4);
  P.biasT = (float*)take((size_t)24 * 129 * 4);
  P.bar = (unsigned*)take((size_t)BAR_TOTAL_WORDS * 4);
  P.WinTtmp = P.Qr;
  P.WpgTtmp = P.Rg;
  P.WqTtmp = P.Rg + (size_t)2048 * 2048;
  P.merged = P.og;
  P.y = (float*)P.Qr;
  P.hb = (u16*)take((size_t)TS * 2048 * 2);
  P.qb = P.AQ;
  P.peb = (u16*)take((size_t)TS * 2048 * 2);
  if (off > ws_size) fprintf(stderr, "workspace too small: need %zu have %zu\n", off, ws_size);
  for (int d = 0; d < 64; ++d) P.ropec[d] = (float)(pow(10000.0, -(double)d / 63.0) / (2.0 * M_PI));

  static int grid_blocks = 0;
  if (!grid_blocks) {
    int dev = 0, cus = 0, per_cu = 0;
    (void)hipGetDevice(&dev);
    (void)hipDeviceGetAttribute(&cus, hipDeviceAttributeMultiprocessorCount, dev);
    (void)hipOccupancyMaxActiveBlocksPerMultiprocessor(&per_cu, fwd_megakernel, NTHR, 0);
    if (per_cu > 2) per_cu = 2;
    if (per_cu < 1) per_cu = 1;
    grid_blocks = cus * per_cu;
  }
  (void)hipMemsetAsync(P.bar, 0, (size_t)BAR_TOTAL_WORDS * 4, stream);
  void* args[] = {&P};
  hipError_t e = hipLaunchCooperativeKernel((void*)fwd_megakernel, dim3(grid_blocks), dim3(NTHR), args, 0, stream);
  if (e != hipSuccess) fprintf(stderr, "cooperative launch failed: %s (grid %d)\n", hipGetErrorString(e), grid_blocks);
}
```

```cpp
#include <hip/hip_runtime.h>
#include <hip/hip_cooperative_groups.h>
#include <cstdio>
#include <cmath>
#include <cstring>
namespace cg = cooperative_groups;

typedef unsigned short u16;
typedef short bf16x8 __attribute__((ext_vector_type(8)));
typedef float f32x4 __attribute__((ext_vector_type(4)));
typedef __bf16 bf16x2_t __attribute__((ext_vector_type(2)));
typedef float f32x2_t __attribute__((ext_vector_type(2)));
typedef unsigned u32x4 __attribute__((ext_vector_type(4)));
typedef unsigned u32x2 __attribute__((ext_vector_type(2)));
typedef int i32x4 __attribute__((ext_vector_type(4)));
typedef unsigned char u8;

#define DEV __device__ __forceinline__
#define MFMA(a, b, c) __builtin_amdgcn_mfma_f32_16x16x32_bf16((a), (b), (c), 0, 0, 0)

constexpr int TS = 8192;
constexpr int DM = 2048;
constexpr int NTHR = 256;
constexpr int JSPLIT = 6144;
constexpr int SMEM_BYTES = 74752;
constexpr float DN_ALPHA = 1.189207115002721f;
constexpr float LN_EPS = 1e-5f;
constexpr float QK_SCALE = 0.08838834764831845f;
constexpr float LOG2E = 1.4426950408889634f;

struct Params {
  const float *x_prompt, *x_sample, *p_prompt, *p_sample, *w_in, *decay_logit, *w_ret_o, *w_att_o, *w_out, *rel_bias,
      *ln1_g, *ln1_b, *peer_wq, *peer_keys, *peer_u, *peer_v, *w_pe, *w_pg, *ln2_g, *ln2_b;
  float* out;
  u16 *WretT, *WattT, *WoutT, *WpeT, *keysb, *Ub, *Vb;
  u16 *pb, *Qr, *Kr, *KrT, *VrT, *Rg, *AQ, *AK, *AVT, *GA, *GB, *og, *ret, *att, *merged, *hb, *qb, *peb;
  float *lse, *y, *gw, *biasT, *su, *sv, *sx, *sw, *swpg, *swq, *sh;
  u8 *xq8, *Win8, *Wpg8, *Wq8, *h8;
  u16 *WinTtmp, *WpgTtmp, *WqTtmp;
  int* eidx;
  unsigned* bar;
  float ropec[64];
};

typedef const __attribute__((address_space(3))) Params LParams;
#define PREF LParams&
DEV LParams* launderP(LParams* p) { asm volatile("" : "+v"(p)); return p; }
DEV int tid_() { int t = threadIdx.x; asm volatile("" : "+v"(t)); return t; }
DEV int bid_() { int t = blockIdx.x; asm volatile("" : "+s"(t)); return t; }
DEV int gdim_() { int t = gridDim.x; asm volatile("" : "+s"(t)); return t; }
DEV unsigned pack2(float a, float b) {
  f32x2_t v = {a, b};
  bf16x2_t r = __builtin_convertvector(v, bf16x2_t);
  return __builtin_bit_cast(unsigned, r);
}
DEV float bflo(unsigned u) { return __uint_as_float(u << 16); }
DEV float bfhi(unsigned u) { return __uint_as_float(u & 0xffff0000u); }
DEV u16 f2bf(float a) { return (u16)(pack2(a, 0.f) & 0xffffu); }
DEV float sigm(float x) { return 1.f / (1.f + __expf(-x)); }
DEV float wsum(float v) {
  v += __shfl_xor(v, 32); v += __shfl_xor(v, 16); v += __shfl_xor(v, 8);
  v += __shfl_xor(v, 4);  v += __shfl_xor(v, 2);  v += __shfl_xor(v, 1);
  return v;
}
DEV float log_sigmoid(float x) { return -log1pf(expf(-x)); }

DEV int rowmap(int p, int Sshift, int dl) {
  int seq = p >> Sshift, pp = p & ((1 << Sshift) - 1);
  int Lshift = Sshift - dl;
  int r = pp >> Lshift, l = pp & ((1 << Lshift) - 1);
  return (seq << Sshift) + (l << dl) + r;
}
DEV int posmap(int m, int Sshift, int dl) {
  int seq = m >> Sshift, s = m & ((1 << Sshift) - 1);
  int Lshift = Sshift - dl;
  return (seq << Sshift) + ((s & ((1 << dl) - 1)) << Lshift) + (s >> dl);
}

DEV const float* x_slab(PREF P, int slab) {
  return slab < 2 ? P.x_prompt + (size_t)slab * TS * DM : P.x_sample + (size_t)(slab - 2) * TS * DM;
}
DEV const float* p_slab(PREF P, int slab) {
  return slab < 2 ? P.p_prompt + (size_t)slab * TS * 256 : P.p_sample + (size_t)(slab - 2) * TS * 256;
}

__device__ void convert_bf16(const float* __restrict__ src, u16* __restrict__ dst, size_t n8) {
  for (size_t i = (size_t)bid_() * NTHR + tid_(); i < n8; i += (size_t)gdim_() * NTHR) {
    float4 a = ((const float4*)src)[2 * i], b = ((const float4*)src)[2 * i + 1];
    uint4 o;
    o.x = pack2(a.x, a.y); o.y = pack2(a.z, a.w); o.z = pack2(b.x, b.y); o.w = pack2(b.z, b.w);
    ((uint4*)dst)[i] = o;
  }
}

DEV float wmax(float v) {
  v = fmaxf(v, __shfl_xor(v, 32)); v = fmaxf(v, __shfl_xor(v, 16)); v = fmaxf(v, __shfl_xor(v, 8));
  v = fmaxf(v, __shfl_xor(v, 4));  v = fmaxf(v, __shfl_xor(v, 2));  v = fmaxf(v, __shfl_xor(v, 1));
  return v;
}
DEV int wsum_i(int v) {
  v += __shfl_xor(v, 32); v += __shfl_xor(v, 16); v += __shfl_xor(v, 8);
  v += __shfl_xor(v, 4);  v += __shfl_xor(v, 2);  v += __shfl_xor(v, 1);
  return v;
}
DEV unsigned q4(float a, float b, float c, float d, float inv, int off) {
  int qa = (int)rintf(a * inv), qb = (int)rintf(b * inv), qc = (int)rintf(c * inv), qd = (int)rintf(d * inv);
  qa = min(max(qa, -127), 127) + off; qb = min(max(qb, -127), 127) + off;
  qc = min(max(qc, -127), 127) + off; qd = min(max(qd, -127), 127) + off;
  return (unsigned)(qa & 255) | ((unsigned)(qb & 255) << 8) | ((unsigned)(qc & 255) << 16) | ((unsigned)(qd & 255) << 24);
}
__device__ void quant_rows_f32(const float* __restrict__ src, unsigned char* __restrict__ dst, float* __restrict__ scales,
                               int nrows, int off) {
  const int lane = tid_() & 63, wid = tid_() >> 6;
  for (int row = bid_() * 4 + wid; row < nrows; row += gdim_() * 4) {
    const float* r = src + (size_t)row * 2048 + lane * 16;
    float v[32];
#pragma unroll
    for (int hf = 0; hf < 2; ++hf)
#pragma unroll
      for (int c = 0; c < 4; ++c) {
        float4 x = *(const float4*)(r + hf * 1024 + c * 4);
        v[hf * 16 + c * 4 + 0] = x.x; v[hf * 16 + c * 4 + 1] = x.y; v[hf * 16 + c * 4 + 2] = x.z; v[hf * 16 + c * 4 + 3] = x.w;
      }
    float am = 0.f;
#pragma unroll
    for (int e = 0; e < 32; ++e) am = fmaxf(am, fabsf(v[e]));
    am = wmax(am);
    const float sc = am > 0.f ? am * (1.f / 127.f) : 1.f;
    const float inv = 1.f / sc;
#pragma unroll
    for (int hf = 0; hf < 2; ++hf) {
      u32x4 o;
      o.x = q4(v[hf * 16 + 0], v[hf * 16 + 1], v[hf * 16 + 2], v[hf * 16 + 3], inv, off);
      o.y = q4(v[hf * 16 + 4], v[hf * 16 + 5], v[hf * 16 + 6], v[hf * 16 + 7], inv, off);
      o.z = q4(v[hf * 16 + 8], v[hf * 16 + 9], v[hf * 16 + 10], v[hf * 16 + 11], inv, off);
      o.w = q4(v[hf * 16 + 12], v[hf * 16 + 13], v[hf * 16 + 14], v[hf * 16 + 15], inv, off);
      *(u32x4*)(dst + (size_t)row * 2048 + hf * 1024 + lane * 16) = o;
    }
    if (lane == 0) scales[row] = sc;
  }
}

__device__ void quant_rows_bf16(const u16* __restrict__ src, u8* __restrict__ dst, float* __restrict__ scales, int nrows) {
  const int lane = tid_() & 63, wid = tid_() >> 6;
  for (int row = bid_() * 4 + wid; row < nrows; row += gdim_() * 4) {
    const u16* r = src + (size_t)row * 2048 + lane * 16;
    float v[32];
    {
      u32x4 a = *(const u32x4*)r, b = *(const u32x4*)(r + 8), c = *(const u32x4*)(r + 1024), d = *(const u32x4*)(r + 1032);
      v[0] = bflo(a.x); v[1] = bfhi(a.x); v[2] = bflo(a.y); v[3] = bfhi(a.y); v[4] = bflo(a.z); v[5] = bfhi(a.z); v[6] = bflo(a.w); v[7] = bfhi(a.w);
      v[8] = bflo(b.x); v[9] = bfhi(b.x); v[10] = bflo(b.y); v[11] = bfhi(b.y); v[12] = bflo(b.z); v[13] = bfhi(b.z); v[14] = bflo(b.w); v[15] = bfhi(b.w);
      v[16] = bflo(c.x); v[17] = bfhi(c.x); v[18] = bflo(c.y); v[19] = bfhi(c.y); v[20] = bflo(c.z); v[21] = bfhi(c.z); v[22] = bflo(c.w); v[23] = bfhi(c.w);
      v[24] = bflo(d.x); v[25] = bfhi(d.x); v[26] = bflo(d.y); v[27] = bfhi(d.y); v[28] = bflo(d.z); v[29] = bfhi(d.z); v[30] = bflo(d.w); v[31] = bfhi(d.w);
    }
    float am = 0.f;
#pragma unroll
    for (int e = 0; e < 32; ++e) am = fmaxf(am, fabsf(v[e]));
    am = wmax(am);
    const float sc = am > 0.f ? am * (1.f / 127.f) : 1.f;
    const float inv = 1.f / sc;
#pragma unroll
    for (int hf = 0; hf < 2; ++hf) {
      u32x4 o;
      o.x = q4(v[hf * 16 + 0], v[hf * 16 + 1], v[hf * 16 + 2], v[hf * 16 + 3], inv, 0);
      o.y = q4(v[hf * 16 + 4], v[hf * 16 + 5], v[hf * 16 + 6], v[hf * 16 + 7], inv, 0);
      o.z = q4(v[hf * 16 + 8], v[hf * 16 + 9], v[hf * 16 + 10], v[hf * 16 + 11], inv, 0);
      o.w = q4(v[hf * 16 + 12], v[hf * 16 + 13], v[hf * 16 + 14], v[hf * 16 + 15], inv, 0);
      *(u32x4*)(dst + (size_t)row * 2048 + hf * 1024 + lane * 16) = o;
    }
    if (lane == 0) scales[row] = sc;
  }
}

__device__ void transpose_convert(const float* __restrict__ src, int K, int N, u16* __restrict__ dst, char* smem) {
  float* tile = (float*)smem;
  const int tilesN = N >> 6, ntiles = (K >> 6) * tilesN;
  const int tid = tid_();
  for (int t = bid_(); t < ntiles; t += gdim_()) {
    const int k0 = (t / tilesN) << 6, n0 = (t % tilesN) << 6;
    __syncthreads();
    const int ty = tid >> 4, tx = tid & 15;
#pragma unroll
    for (int pp = 0; pp < 4; ++pp) {
      int k = ty + 16 * pp;
      float4 v = *(const float4*)(src + (size_t)(k0 + k) * N + n0 + tx * 4);
      float* d = tile + k * 65 + tx * 4;
      d[0] = v.x; d[1] = v.y; d[2] = v.z; d[3] = v.w;
    }
    __syncthreads();
    const int n = tid >> 2, ks = (tid & 3) * 16;
    unsigned o[8];
#pragma unroll
    for (int e = 0; e < 8; ++e) o[e] = pack2(tile[(ks + 2 * e) * 65 + n], tile[(ks + 2 * e + 1) * 65 + n]);
    uint4* d = (uint4*)(dst + (size_t)(n0 + n) * K + k0 + ks);
    d[0] = make_uint4(o[0], o[1], o[2], o[3]);
    d[1] = make_uint4(o[4], o[5], o[6], o[7]);
  }
}

DEV f32x4 mma_step(bf16x8 a, bf16x8 b, f32x4 c) { return MFMA(a, b, c); }
DEV i32x4 mma_step(i32x4 a, i32x4 b, i32x4 c) { return __builtin_amdgcn_mfma_i32_16x16x64_i8(a, b, c, 0, 0, 0); }

template <class FragT, class AccT>
DEV void gemm_core_t(const char* __restrict__ A, size_t lda_bytes, const char* __restrict__ Bt, size_t ldb_bytes, int kbytes,
                     int m0, int n0, int Sshift, int dl, char* smem, AccT (&acc)[4][4]) {
  const int tid = tid_(), lane = tid & 63, wid = tid >> 6, wm = wid >> 1, wn = wid & 1;
  const int l15 = lane & 15, q = lane >> 4;
  const int srow = lane >> 3, schunk = (lane & 7) ^ (lane >> 3);
  const char* ap[4];
  const char* bp[4];
#pragma unroll
  for (int u = 0; u < 4; ++u) {
    int r = (wid * 4 + u) * 8 + srow;
    int ar = rowmap(m0 + r, Sshift, dl);
    ap[u] = A + (size_t)ar * lda_bytes + schunk * 16;
    bp[u] = Bt + (size_t)(n0 + r) * ldb_bytes + schunk * 16;
  }
#pragma unroll
  for (int i = 0; i < 4; ++i)
#pragma unroll
    for (int j = 0; j < 4; ++j) acc[i][j] = AccT{0, 0, 0, 0};
  const int nk = kbytes >> 7;
  __syncthreads();
#pragma unroll
  for (int u = 0; u < 4; ++u) {
    __builtin_amdgcn_global_load_lds((const unsigned*)ap[u], (unsigned*)(smem + (wid * 4 + u) * 1024 + lane * 16), 16, 0, 0);
    __builtin_amdgcn_global_load_lds((const unsigned*)bp[u], (unsigned*)(smem + 16384 + (wid * 4 + u) * 1024 + lane * 16), 16, 0, 0);
  }
  const unsigned sbase = (unsigned)(unsigned long)((__attribute__((address_space(3))) char*)smem);
  const unsigned sq0 = (unsigned)((q ^ (l15 & 7)) << 4);
  const unsigned a0 = sbase + (unsigned)((wm * 64 + l15) * 128) + sq0;
  const unsigned b0 = sbase + 16384u + (unsigned)((wn * 32 + l15) * 128) + sq0;
  asm volatile("s_waitcnt vmcnt(0)" ::: "memory");
  __syncthreads();
  for (int kt = 0; kt < nk; ++kt) {
    const unsigned so = (unsigned)(kt & 1) * 32768u;
    char* nxt = smem + ((kt + 1) & 1) * 32768;
    if (kt + 1 < nk) {
#pragma unroll
      for (int u = 0; u < 4; ++u) {
        __builtin_amdgcn_global_load_lds((const unsigned*)(ap[u] + (size_t)(kt + 1) * 128), (unsigned*)(nxt + (wid * 4 + u) * 1024 + lane * 16), 16, 0, 0);
        __builtin_amdgcn_global_load_lds((const unsigned*)(bp[u] + (size_t)(kt + 1) * 128), (unsigned*)(nxt + 16384 + (wid * 4 + u) * 1024 + lane * 16), 16, 0, 0);
      }
    }
    FragT xa[2][4], wb[2][4];
    asm volatile(
        "ds_read_b128 %0, %16\n\t"
        "ds_read_b128 %1, %16 offset:2048\n\t"
        "ds_read_b128 %2, %16 offset:4096\n\t"
        "ds_read_b128 %3, %16 offset:6144\n\t"
        "ds_read_b128 %4, %18\n\t"
        "ds_read_b128 %5, %18 offset:2048\n\t"
        "ds_read_b128 %6, %18 offset:8192\n\t"
        "ds_read_b128 %7, %18 offset:10240\n\t"
        "ds_read_b128 %8, %17\n\t"
        "ds_read_b128 %9, %17 offset:2048\n\t"
        "ds_read_b128 %10, %17 offset:4096\n\t"
        "ds_read_b128 %11, %17 offset:6144\n\t"
        "ds_read_b128 %12, %19\n\t"
        "ds_read_b128 %13, %19 offset:2048\n\t"
        "ds_read_b128 %14, %19 offset:8192\n\t"
        "ds_read_b128 %15, %19 offset:10240\n\t"
        "s_waitcnt lgkmcnt(8)"
        : "=&v"(xa[0][0]), "=&v"(xa[0][1]), "=&v"(xa[0][2]), "=&v"(xa[0][3]), "=&v"(wb[0][0]), "=&v"(wb[0][1]), "=&v"(wb[0][2]),
          "=&v"(wb[0][3]), "=&v"(xa[1][0]), "=&v"(xa[1][1]), "=&v"(xa[1][2]), "=&v"(xa[1][3]), "=&v"(wb[1][0]), "=&v"(wb[1][1]),
          "=&v"(wb[1][2]), "=&v"(wb[1][3])
        : "v"(a0 + so), "v"((a0 ^ 64u) + so), "v"(b0 + so), "v"((b0 ^ 64u) + so)
        : "memory");
    __builtin_amdgcn_s_setprio(1);
#pragma unroll
    for (int i = 0; i < 4; ++i)
#pragma unroll
      for (int j = 0; j < 4; ++j) acc[i][j] = mma_step(wb[0][j], xa[0][i], acc[i][j]);
    asm volatile("s_waitcnt lgkmcnt(0)"
                 : "+v"(xa[1][0]), "+v"(xa[1][1]), "+v"(xa[1][2]), "+v"(xa[1][3]), "+v"(wb[1][0]), "+v"(wb[1][1]), "+v"(wb[1][2]),
                   "+v"(wb[1][3]), "+v"(acc[0][0]), "+v"(acc[0][1]), "+v"(acc[0][2]), "+v"(acc[0][3]), "+v"(acc[1][0]),
                   "+v"(acc[1][1]), "+v"(acc[1][2]), "+v"(acc[1][3]), "+v"(acc[2][0]), "+v"(acc[2][1]), "+v"(acc[2][2]),
                   "+v"(acc[2][3]), "+v"(acc[3][0]), "+v"(acc[3][1]), "+v"(acc[3][2]), "+v"(acc[3][3])
                 :
                 : "memory");
#pragma unroll
    for (int i = 0; i < 4; ++i)
#pragma unroll
      for (int j = 0; j < 4; ++j) acc[i][j] = mma_step(wb[1][j], xa[1][i], acc[i][j]);
    __builtin_amdgcn_s_setprio(0);
    asm volatile("s_waitcnt vmcnt(0)"
                 : "+v"(acc[0][0]), "+v"(acc[0][1]), "+v"(acc[0][2]), "+v"(acc[0][3]), "+v"(acc[1][0]), "+v"(acc[1][1]),
                   "+v"(acc[1][2]), "+v"(acc[1][3]), "+v"(acc[2][0]), "+v"(acc[2][1]), "+v"(acc[2][2]), "+v"(acc[2][3]),
                   "+v"(acc[3][0]), "+v"(acc[3][1]), "+v"(acc[3][2]), "+v"(acc[3][3])
                 :
                 : "memory");
    __syncthreads();
  }
}

DEV void gemm_core(const u16* __restrict__ A, int lda, const u16* __restrict__ Bt, int ldb, int K, int m0, int n0,
                   int Sshift, int dl, char* smem, f32x4 (&acc)[4][4]) {
  gemm_core_t<bf16x8, f32x4>((const char*)A, (size_t)lda * 2, (const char*)Bt, (size_t)ldb * 2, K * 2, m0, n0, Sshift, dl, smem, acc);
}
DEV void gemm_core_i8(const u8* __restrict__ A, int lda, const u8* __restrict__ Bt, int ldb, int K, int m0, int n0,
                      int Sshift, int dl, char* smem, i32x4 (&acc)[4][4]) {
  gemm_core_t<i32x4, i32x4>((const char*)A, (size_t)lda, (const char*)Bt, (size_t)ldb, K, m0, n0, Sshift, dl, smem, acc);
}

DEV void tile_map(int t, int ntx, int& mt, int& nt) {
  int x = t & 7, u = t >> 3;
  int grp = u / (8 * ntx), rem = u % (8 * ntx);
  nt = x * ntx + (rem >> 3);
  mt = grp * 8 + (rem & 7);
}

DEV void store_nat(u16* buf, int ld, int row, int col, f32x4 v) {
  uint2 o; o.x = pack2(v[0], v[1]); o.y = pack2(v[2], v[3]);
  *(uint2*)(buf + (size_t)row * ld + col) = o;
}
DEV void store_tr(u16* buf, int col, int m, f32x4 v) {
#pragma unroll
  for (int r = 0; r < 4; ++r) buf[(size_t)(col + r) * TS + m] = f2bf(v[r]);
}

DEV void stage_tile_bf16(char* smem, const f32x4 (&v)[4][4], u16* buf, int ld, int m0, int col0) {
  const int tid = tid_(), lane = tid & 63, wid = tid >> 6, wm = wid >> 1, wn = wid & 1, l15 = lane & 15, q = lane >> 4;
#pragma unroll
  for (int i = 0; i < 4; ++i)
#pragma unroll
    for (int j = 0; j < 4; ++j) {
      const int rl = wm * 64 + i * 16 + l15, cl = (j & 1) * 16 + wn * 32 + (j >> 1) * 64 + q * 4;
      u32x2 o; o.x = pack2(v[i][j][0], v[i][j][1]); o.y = pack2(v[i][j][2], v[i][j][3]);
      *(u32x2*)(smem + rl * 272 + cl * 2) = o;
    }
  __syncthreads();
#pragma unroll
  for (int k = 0; k < 8; ++k) {
    const int chunk = tid + 256 * k, rl = chunk >> 4, c16 = chunk & 15;
    u32x4 d = *(const u32x4*)(smem + rl * 272 + c16 * 16);
    *(u32x4*)(buf + (size_t)(m0 + rl) * ld + col0 + c16 * 8) = d;
  }
}

__device__ __forceinline__ void phase_gemm1(PREF P, int slab, char* smem) {
  const int Sshift = slab < 2 ? 12 : 13;
  const int lane = tid_() & 63, wid = tid_() >> 6, wm = wid >> 1, wn = wid & 1, l15 = lane & 15, q = lane >> 4;
  for (int t = bid_(); t < 64 * 152; t += gdim_()) {
    int mt, nt;
    tile_map(t, 19, mt, nt);
    const int m0 = mt * 128, n0 = nt * 128;
    int region, dl = 0;
    if (n0 < 1024) region = 0;
    else if (n0 < 2048) region = 1;
    else if (n0 < 4096) region = 2;
    else if (n0 < 6144) region = 3;
    else if (n0 < 9216) region = 4;
    else if (n0 < 12288) region = 5;
    else if (n0 < 15360) region = 6;
    else if (n0 < 17408) region = 7;
    else region = 8;
    if (region >= 4 && region <= 6) dl = 2 * ((n0 - (6144 + (region - 4) * 3072)) >> 10);
    f32x4 acc[4][4];
    {
      i32x4 iacc[4][4];
      gemm_core_i8(P.xq8, DM, P.Win8, DM, DM, m0, n0, Sshift, dl, smem, iacc);
#pragma unroll
      for (int i = 0; i < 4; ++i) {
        const float sxr = P.sx[rowmap(m0 + wm * 64 + i * 16 + l15, Sshift, dl)];
#pragma unroll
        for (int j = 0; j < 4; ++j) {
          const float4 swc = *(const float4*)(P.sw + n0 + (j & 1) * 16 + wn * 32 + (j >> 1) * 64 + q * 4);
          acc[i][j][0] = (float)iacc[i][j][0] * sxr * swc.x; acc[i][j][1] = (float)iacc[i][j][1] * sxr * swc.y;
          acc[i][j][2] = (float)iacc[i][j][2] * sxr * swc.z; acc[i][j][3] = (float)iacc[i][j][3] * sxr * swc.w;
        }
      }
    }
    if (region <= 1) {
#pragma unroll
      for (int i = 0; i < 4; ++i) {
        const int row = m0 + wm * 64 + i * 16 + l15;
        const float s = (float)(row & ((1 << Sshift) - 1));
#pragma unroll
        for (int jj = 0; jj < 2; ++jj)
#pragma unroll
          for (int r = 0; r < 4; ++r) {
            const int d = jj * 16 + wn * 32 + q * 4 + r;
            float fr = __builtin_amdgcn_fractf(s * P.ropec[d]);
            float cs = __builtin_amdgcn_cosf(fr), sn = __builtin_amdgcn_sinf(fr);
            float t1 = acc[i][jj][r], t2 = acc[i][jj + 2][r];
            float o1 = t1 * cs - t2 * sn, o2 = t1 * sn + t2 * cs;
            if (region == 1) { o1 *= QK_SCALE; o2 *= QK_SCALE; }
            acc[i][jj][r] = o1;
            acc[i][jj + 2][r] = o2;
          }
      }
    }
    u16* nbuf = nullptr; int nld = 0, ncol = 0;
    u16* tbuf = nullptr; int tcol = 0;
    switch (region) {
      case 0: nbuf = P.Qr; nld = 1024; ncol = n0; break;
      case 1: nbuf = P.Kr; nld = 1024; ncol = n0 - 1024; tbuf = P.KrT; tcol = n0 - 1024; break;
      case 2: tbuf = P.VrT; tcol = n0 - 2048; break;
      case 3: nbuf = P.Rg; nld = 2048; ncol = n0 - 4096; break;
      case 4: nbuf = P.AQ; nld = 3072; ncol = n0 - 6144; break;
      case 5: nbuf = P.AK; nld = 3072; ncol = n0 - 9216; break;
      case 6: tbuf = P.AVT; tcol = n0 - 12288; break;
      default: break;
    }
    if (region == 4) {
#pragma unroll
      for (int i = 0; i < 4; ++i)
#pragma unroll
        for (int j = 0; j < 4; ++j) acc[i][j] = acc[i][j] * QK_SCALE;
    }
    const int tid = tid_();
    if (region >= 7) {
      u8* gb8 = (u8*)(region == 7 ? P.GA : P.GB);
      const int gcol = n0 - (region == 7 ? 15360 : 17408);
#pragma unroll
      for (int i = 0; i < 4; ++i)
#pragma unroll
        for (int j = 0; j < 4; ++j) {
          const int rl = wm * 64 + i * 16 + l15, cl = (j & 1) * 16 + wn * 32 + (j >> 1) * 64 + q * 4;
          const unsigned b0 = (unsigned)(sigm(acc[i][j][0]) * 255.f + 0.5f), b1 = (unsigned)(sigm(acc[i][j][1]) * 255.f + 0.5f);
          const unsigned b2 = (unsigned)(sigm(acc[i][j][2]) * 255.f + 0.5f), b3 = (unsigned)(sigm(acc[i][j][3]) * 255.f + 0.5f);
          *(unsigned*)(smem + rl * 144 + cl) = b0 | (b1 << 8) | (b2 << 16) | (b3 << 24);
        }
      __syncthreads();
#pragma unroll
      for (int k = 0; k < 4; ++k) {
        const int chunk = tid + 256 * k, rl = chunk >> 3, c16 = chunk & 7;
        u32x4 d = *(const u32x4*)(smem + rl * 144 + c16 * 16);
        __builtin_nontemporal_store(d, (u32x4*)(gb8 + (size_t)(m0 + rl) * 2048 + gcol + c16 * 16));
      }
    }
    if (nbuf) {
#pragma unroll
      for (int i = 0; i < 4; ++i)
#pragma unroll
        for (int j = 0; j < 4; ++j) {
          const int rl = wm * 64 + i * 16 + l15, cl = (j & 1) * 16 + wn * 32 + (j >> 1) * 64 + q * 4;
          u32x2 o; o.x = pack2(acc[i][j][0], acc[i][j][1]); o.y = pack2(acc[i][j][2], acc[i][j][3]);
          *(u32x2*)(smem + rl * 272 + cl * 2) = o;
        }
      __syncthreads();
#pragma unroll
      for (int k = 0; k < 8; ++k) {
        const int chunk = tid + 256 * k, rl = chunk >> 4, c16 = chunk & 15;
        u32x4 d = *(const u32x4*)(smem + rl * 272 + c16 * 16);
        __builtin_nontemporal_store(d, (u32x4*)(nbuf + (size_t)(m0 + rl) * nld + ncol + c16 * 8));
      }
      if (tbuf) __syncthreads();
    }
    if (tbuf) {
#pragma unroll
      for (int i = 0; i < 4; ++i)
#pragma unroll
        for (int j = 0; j < 4; ++j) {
          const int rl = wm * 64 + i * 16 + l15, cl = (j & 1) * 16 + wn * 32 + (j >> 1) * 64 + q * 4;
#pragma unroll
          for (int r = 0; r < 4; ++r) *(u16*)(smem + (cl + r) * 272 + rl * 2) = f2bf(acc[i][j][r]);
        }
      __syncthreads();
#pragma unroll
      for (int k = 0; k < 8; ++k) {
        const int chunk = tid + 256 * k, cl = chunk >> 4, c16 = chunk & 15;
        u32x4 d = *(const u32x4*)(smem + cl * 272 + c16 * 16);
        __builtin_nontemporal_store(d, (u32x4*)(tbuf + (size_t)(tcol + cl) * TS + m0 + c16 * 8));
      }
    }
  }
}

template <class F>
DEV void dma_rows256(F rowptr, int nrows, char* lds) {
  const int lane = tid_() & 63, wid = tid_() >> 6;
  for (int blk = wid; blk < (nrows >> 2); blk += 4) {
    const int row = blk * 4 + (lane >> 4);
    const int c = (lane & 15) ^ (row & 15);
    const u16* src = rowptr(row) + c * 8;
    __builtin_amdgcn_global_load_lds((const unsigned*)src, (unsigned*)(lds + blk * 1024 + lane * 16), 16, 0, 0);
  }
}
DEV bf16x8 rd128(const char* lds, int row, int chunk) {
  return *(const bf16x8*)(lds + row * 256 + ((chunk ^ (row & 15)) << 4));
}
DEV u32x2 rd64(const char* lds, int row, int byteoff) {
  return *(const u32x2*)(lds + row * 256 + ((((byteoff >> 4)) ^ (row & 15)) << 4) + (byteoff & 15));
}
#define DMA_WAIT_SYNC() do { asm volatile("s_waitcnt vmcnt(0)" ::: "memory"); __syncthreads(); } while (0)

__device__ __forceinline__ void ret_kv_item(PREF P, int w, u16* ST, char* smem) {
  const int lane = tid_() & 63, wid = tid_() >> 6, l15 = lane & 15, q = lane >> 4;
  const int dir = w & 1, h = (w >> 1) & 7, n = w >> 4;
  const int tok0 = n * 128;
  const float l2 = log_sigmoid(P.decay_logit[dir * 8 + h]) * LOG2E;
  __syncthreads();
  {
    const u16* kt = P.KrT + (size_t)(h * 128) * TS + tok0;
    dma_rows256([&](int row) { return kt + (size_t)row * TS; }, 128, smem);
  }
  u32x4 vraw[4][4];
  {
    const u16* vbase = P.VrT + (size_t)(h * 256 + wid * 64 + l15) * TS + tok0 + q * 8;
#pragma unroll
    for (int kk = 0; kk < 4; ++kk)
#pragma unroll
      for (int jd = 0; jd < 4; ++jd) vraw[kk][jd] = *(const u32x4*)(vbase + (size_t)jd * 16 * TS + kk * 32);
  }
  f32x4 acc[8][4];
#pragma unroll
  for (int a = 0; a < 8; ++a)
#pragma unroll
    for (int b = 0; b < 4; ++b) acc[a][b] = f32x4{0.f, 0.f, 0.f, 0.f};
  DMA_WAIT_SYNC();
#pragma unroll
  for (int kk = 0; kk < 4; ++kk) {
    const int tb = kk * 32 + q * 8;
    float z[8];
#pragma unroll
    for (int e = 0; e < 8; ++e) {
      int t = tb + e;
      z[e] = __builtin_amdgcn_exp2f(l2 * (float)(dir == 0 ? 127 - t : t));
    }
    bf16x8 vb[4];
#pragma unroll
    for (int jd = 0; jd < 4; ++jd) {
      u32x4 raw = vraw[kk][jd];
      u32x4 o;
      o.x = pack2(bflo(raw.x) * z[0], bfhi(raw.x) * z[1]);
      o.y = pack2(bflo(raw.y) * z[2], bfhi(raw.y) * z[3]);
      o.z = pack2(bflo(raw.z) * z[4], bfhi(raw.z) * z[5]);
      o.w = pack2(bflo(raw.w) * z[6], bfhi(raw.w) * z[7]);
      vb[jd] = __builtin_bit_cast(bf16x8, o);
    }
#pragma unroll
    for (int ik = 0; ik < 8; ++ik) {
      bf16x8 ka = rd128(smem, ik * 16 + l15, kk * 4 + q);
#pragma unroll
      for (int jd = 0; jd < 4; ++jd) acc[ik][jd] = MFMA(ka, vb[jd], acc[ik][jd]);
    }
  }
  u16* dst = ST + ((size_t)((n * 8 + h) * 2 + dir)) * 32768 + (size_t)(wid * 64) * 128;
  __syncthreads();
  char* wst = smem + wid * 16384;
#pragma unroll
  for (int ik = 0; ik < 8; ++ik)
#pragma unroll
    for (int jd = 0; jd < 4; ++jd) {
      const int r = jd * 16 + l15, c = ik * 2 + (q >> 1);
      u32x2 o; o.x = pack2(acc[ik][jd][0], acc[ik][jd][1]); o.y = pack2(acc[ik][jd][2], acc[ik][jd][3]);
      *(u32x2*)(wst + r * 256 + ((c ^ (r & 15)) << 4) + (q & 1) * 8) = o;
    }
#pragma unroll
  for (int k = 0; k < 16; ++k) {
    const int chunk = k * 64 + lane, r = chunk >> 4, p = chunk & 15;
    u32x4 d = *(const u32x4*)(wst + r * 256 + (p << 4));
    *(u32x4*)(dst + (size_t)r * 128 + ((p ^ (r & 15)) << 3)) = d;
  }
}

__device__ __forceinline__ void attn_item(PREF P, int w, int Sshift, char* smem) {
  const int lane = tid_() & 63, wid = tid_() >> 6, l15 = lane & 15, q = lane >> 4;
  const int qb = w & 127, hs = (w >> 7) & 7, gi = w >> 10;
  const int dl = gi * 2, Lshift = Sshift - dl, L = 1 << Lshift;
  const int p0 = qb * 64, l0 = p0 & (L - 1), pbase = p0 - l0;
  const int hcol = (gi * 8 + hs) * 128;
  const int li = l0 + wid * 16 + l15;
  char* KW = smem;
  char* VH = smem + 49152;
  auto dma_vhalf = [&](char* dstb, int half) {
    for (int ins = wid; ins < 25; ins += 4) {
      const int sl = ins * 64 + lane;
      const int row = sl / 25;
      int cp = sl - row * 25;
      if (cp == 24) cp = 0;
      int l = l0 - 64 + cp * 8;
      if (l < 0 || l >= L) l = 0;
      const u16* src = P.AVT + (size_t)(hcol + half * 64 + row) * TS + pbase + l;
      __builtin_amdgcn_global_load_lds((const unsigned*)src, (unsigned*)(dstb + ins * 1024 + lane * 16), 16, 0, 0);
    }
  };
  __syncthreads();
  {
    const u16* kb = P.AK + (size_t)pbase * 3072 + hcol;
    dma_rows256([&](int row) { int l = min(max(l0 - 64 + row, 0), L - 1); return kb + (size_t)l * 3072; }, 192, KW);
  }
  dma_vhalf(VH, 0);
  bf16x8 qf[4];
  {
    const u16* qrow = P.AQ + (size_t)(pbase + li) * 3072 + hcol + q * 8;
#pragma unroll
    for (int kd = 0; kd < 4; ++kd) qf[kd] = *(const bf16x8*)(qrow + kd * 32);
  }
  const int kstart = l0 + wid * 16 - 64;
  const float* brow = P.biasT + (gi * 8 + hs) * 129 + 64;
  float bv[10][4];
#pragma unroll
  for (int jt = 0; jt < 10; ++jt)
#pragma unroll
    for (int r = 0; r < 4; ++r) {
      int off = kstart + jt * 16 + q * 4 + r - li;
      bv[jt][r] = brow[min(max(off, -64), 64)];
    }
  DMA_WAIT_SYNC();
  f32x4 sT[10];
#pragma unroll
  for (int jt = 0; jt < 10; ++jt) {
    const int krow = min(wid * 16 + jt * 16 + l15, 191);
    f32x4 sa = {0.f, 0.f, 0.f, 0.f};
#pragma unroll
    for (int kd = 0; kd < 4; ++kd) sa = MFMA(rd128(KW, krow, kd * 4 + q), qf[kd], sa);
    sT[jt] = sa;
  }
  __syncthreads();
  dma_vhalf(KW, 1);
  float mx = -1e30f;
#pragma unroll
  for (int jt = 0; jt < 10; ++jt)
#pragma unroll
    for (int r = 0; r < 4; ++r) {
      int lk = kstart + jt * 16 + q * 4 + r;
      int off = lk - li;
      bool valid = (off >= -64) && (off <= 64) && (lk >= 0) && (lk < L);
      float lg = valid ? sT[jt][r] + bv[jt][r] : -1e30f;
      sT[jt][r] = lg;
      mx = fmaxf(mx, lg);
    }
  mx = fmaxf(mx, __shfl_xor(mx, 16));
  mx = fmaxf(mx, __shfl_xor(mx, 32));
  float den = 0.f;
#pragma unroll
  for (int jt = 0; jt < 10; ++jt)
#pragma unroll
    for (int r = 0; r < 4; ++r) {
      float lg = sT[jt][r];
      float p = (lg > -1e29f) ? __expf(lg - mx) : 0.f;
      sT[jt][r] = p;
      den += p;
    }
  den += __shfl_xor(den, 16);
  den += __shfl_xor(den, 32);
  bf16x8 pf[5];
#pragma unroll
  for (int j2 = 0; j2 < 5; ++j2) {
    u32x4 pp;
    pp.x = pack2(sT[2 * j2][0], sT[2 * j2][1]);
    pp.y = pack2(sT[2 * j2][2], sT[2 * j2][3]);
    pp.z = pack2(sT[2 * j2 + 1][0], sT[2 * j2 + 1][1]);
    pp.w = pack2(sT[2 * j2 + 1][2], sT[2 * j2 + 1][3]);
    pf[j2] = __builtin_bit_cast(bf16x8, pp);
  }
  const float inv = 1.f / den;
  u16* orow = P.og + ((size_t)gi * TS + pbase + li) * 1024 + hs * 128 + q * 4;
#pragma unroll 1
  for (int half = 0; half < 2; ++half) {
    const char* vb = half == 0 ? VH : KW;
    if (half == 1) DMA_WAIT_SYNC();
    f32x4 oT[4];
#pragma unroll
    for (int d = 0; d < 4; ++d) oT[d] = f32x4{0.f, 0.f, 0.f, 0.f};
#pragma unroll
    for (int j2 = 0; j2 < 5; ++j2) {
      int ia = wid * 16 + j2 * 32 + q * 4;
      int ib = ia + 16;
      if (ia >= 192) ia = 0;
      if (ib >= 192) ib = 0;
#pragma unroll
      for (int dvt = 0; dvt < 4; ++dvt) {
        const char* vrow = vb + (dvt * 16 + l15) * 400;
        u32x2 a0 = *(const u32x2*)(vrow + ia * 2), a1 = *(const u32x2*)(vrow + ib * 2);
        u32x4 vv = {a0.x, a0.y, a1.x, a1.y};
        oT[dvt] = MFMA(__builtin_bit_cast(bf16x8, vv), pf[j2], oT[dvt]);
      }
    }
#pragma unroll
    for (int dvt = 0; dvt < 4; ++dvt) {
      uint2 o;
      o.x = pack2(oT[dvt][0] * inv, oT[dvt][1] * inv);
      o.y = pack2(oT[dvt][2] * inv, oT[dvt][3] * inv);
      *(uint2*)(orow + half * 64 + dvt * 16) = o;
    }
  }
  if (q == 0) P.lse[((size_t)gi * TS + pbase + li) * 8 + hs] = mx + logf(den);
}

__device__ __forceinline__ void phase_scan(PREF P, int slab, u16* ST) {
  const int Sshift = slab < 2 ? 12 : 13;
  const int nseq = TS >> Sshift, nC = 1 << (Sshift - 7);
  const int nitems = nseq * 16 * 4096;
  for (int idx = bid_() * NTHR + tid_(); idx < nitems; idx += gdim_() * NTHR) {
    const int e8 = idx & 4095, hd = (idx >> 12) & 15, seq = idx >> 16;
    const int dir = hd & 1, h = hd >> 1;
    const float dec = expf(log_sigmoid(P.decay_logit[dir * 8 + h]) * 128.f);
    float R[8];
#pragma unroll
    for (int e = 0; e < 8; ++e) R[e] = 0.f;
    u16* base = ST + (size_t)hd * 32768 + e8 * 8;
    for (int cc = 0; cc < nC; cc += 4) {
      uint4 v[4];
#pragma unroll
      for (int u = 0; u < 4; ++u) {
        int c = dir == 0 ? (cc + u) : (nC - 1 - cc - u);
        v[u] = *(const uint4*)(base + (size_t)(seq * nC + c) * (16 * 32768));
      }
#pragma unroll
      for (int u = 0; u < 4; ++u) {
        int c = dir == 0 ? (cc + u) : (nC - 1 - cc - u);
        uint4 o;
        o.x = pack2(R[0], R[1]); o.y = pack2(R[2], R[3]); o.z = pack2(R[4], R[5]); o.w = pack2(R[6], R[7]);
        *(uint4*)(base + (size_t)(seq * nC + c) * (16 * 32768)) = o;
        R[0] = R[0] * dec + bflo(v[u].x); R[1] = R[1] * dec + bfhi(v[u].x);
        R[2] = R[2] * dec + bflo(v[u].y); R[3] = R[3] * dec + bfhi(v[u].y);
        R[4] = R[4] * dec + bflo(v[u].z); R[5] = R[5] * dec + bfhi(v[u].z);
        R[6] = R[6] * dec + bflo(v[u].w); R[7] = R[7] * dec + bfhi(v[u].w);
      }
    }
  }
}

DEV unsigned lds_off(const char* p) { return (unsigned)(unsigned long)((__attribute__((address_space(3))) const char*)p); }
DEV void ro_pv(const char* buf, const bf16x8 (&pf)[4], f32x4 (&oT)[8], int l15, int q) {
#pragma unroll
  for (int d = 0; d < 8; ++d) oT[d] = f32x4{0.f, 0.f, 0.f, 0.f};
  const unsigned base = lds_off(buf) + (unsigned)(l15 * 256 + (q & 1) * 8);
#pragma unroll
  for (int j2 = 0; j2 < 4; ++j2) {
    const unsigned a0 = base + (unsigned)((((j2 * 4 + (q >> 1)) ^ l15) & 15) << 4);
    const unsigned a1 = base + (unsigned)((((j2 * 4 + (q >> 1) + 2) ^ l15) & 15) << 4);
    u32x2 v0[8], v1[8];
    asm volatile(
        "ds_read_b64 %0, %16\n\t"
        "ds_read_b64 %1, %16 offset:4096\n\t"
        "ds_read_b64 %2, %16 offset:8192\n\t"
        "ds_read_b64 %3, %16 offset:12288\n\t"
        "ds_read_b64 %4, %16 offset:16384\n\t"
        "ds_read_b64 %5, %16 offset:20480\n\t"
        "ds_read_b64 %6, %16 offset:24576\n\t"
        "ds_read_b64 %7, %16 offset:28672\n\t"
        "ds_read_b64 %8, %17\n\t"
        "ds_read_b64 %9, %17 offset:4096\n\t"
        "ds_read_b64 %10, %17 offset:8192\n\t"
        "ds_read_b64 %11, %17 offset:12288\n\t"
        "ds_read_b64 %12, %17 offset:16384\n\t"
        "ds_read_b64 %13, %17 offset:20480\n\t"
        "ds_read_b64 %14, %17 offset:24576\n\t"
        "ds_read_b64 %15, %17 offset:28672\n\t"
        "s_waitcnt lgkmcnt(0)"
        : "=&v"(v0[0]), "=&v"(v0[1]), "=&v"(v0[2]), "=&v"(v0[3]), "=&v"(v0[4]), "=&v"(v0[5]), "=&v"(v0[6]), "=&v"(v0[7]),
          "=&v"(v1[0]), "=&v"(v1[1]), "=&v"(v1[2]), "=&v"(v1[3]), "=&v"(v1[4]), "=&v"(v1[5]), "=&v"(v1[6]), "=&v"(v1[7])
        : "v"(a0), "v"(a1)
        : "memory");
#pragma unroll
    for (int dvt = 0; dvt < 8; ++dvt) {
      u32x4 vv = {v0[dvt].x, v0[dvt].y, v1[dvt].x, v1[dvt].y};
      oT[dvt] = MFMA(__builtin_bit_cast(bf16x8, vv), pf[j2], oT[dvt]);
    }
  }
}
DEV void ro_cross(const char* buf, float xi, const bf16x8 (&qf)[4], f32x4 (&oT)[8], int l15, int q) {
  const unsigned base = lds_off(buf) + (unsigned)(l15 * 256);
#pragma unroll
  for (int kd = 0; kd < 4; ++kd) {
    u32x4 raw = __builtin_bit_cast(u32x4, qf[kd]);
    u32x4 o;
    o.x = pack2(bflo(raw.x) * xi, bfhi(raw.x) * xi);
    o.y = pack2(bflo(raw.y) * xi, bfhi(raw.y) * xi);
    o.z = pack2(bflo(raw.z) * xi, bfhi(raw.z) * xi);
    o.w = pack2(bflo(raw.w) * xi, bfhi(raw.w) * xi);
    bf16x8 qs = __builtin_bit_cast(bf16x8, o);
    const unsigned a0 = base + (unsigned)((((kd * 4 + q) ^ l15) & 15) << 4);
    bf16x8 ra[8];
    asm volatile(
        "ds_read_b128 %0, %8\n\t"
        "ds_read_b128 %1, %8 offset:4096\n\t"
        "ds_read_b128 %2, %8 offset:8192\n\t"
        "ds_read_b128 %3, %8 offset:12288\n\t"
        "ds_read_b128 %4, %8 offset:16384\n\t"
        "ds_read_b128 %5, %8 offset:20480\n\t"
        "ds_read_b128 %6, %8 offset:24576\n\t"
        "ds_read_b128 %7, %8 offset:28672\n\t"
        "s_waitcnt lgkmcnt(0)"
        : "=&v"(ra[0]), "=&v"(ra[1]), "=&v"(ra[2]), "=&v"(ra[3]), "=&v"(ra[4]), "=&v"(ra[5]), "=&v"(ra[6]), "=&v"(ra[7])
        : "v"(a0)
        : "memory");
#pragma unroll
    for (int dvt = 0; dvt < 8; ++dvt) oT[dvt] = MFMA(ra[dvt], qs, oT[dvt]);
  }
}
#define RO_WAIT_SYNC() do { asm volatile("s_waitcnt vmcnt(0)" : "+v"(oT[0]), "+v"(oT[1]), "+v"(oT[2]), "+v"(oT[3]), \
    "+v"(oT[4]), "+v"(oT[5]), "+v"(oT[6]), "+v"(oT[7]) : : "memory"); __syncthreads(); } while (0)

__device__ __forceinline__ void ret_out_item(PREF P, int w, const u16* ST, char* smem) {
  const int lane = tid_() & 63, wid = tid_() >> 6, l15 = lane & 15, q = lane >> 4;
  const int rh = w & 1, h = (w >> 1) & 7, n = w >> 4;
  const int tok0 = n * 128;
  const int i = rh * 64 + wid * 16 + l15;
  const float l2f = log_sigmoid(P.decay_logit[h]) * LOG2E;
  const float l2b = log_sigmoid(P.decay_logit[8 + h]) * LOG2E;
  char* X = smem;
  char* Y = smem + 32768;
  const u16* kbase = P.Kr + (size_t)tok0 * 1024 + h * 128;
  const u16* vbase = P.VrT + (size_t)(h * 256) * TS + tok0;
  const u16* rbase = ST + ((size_t)((n * 8 + h) * 2)) * 32768;
#define RO_DMA_K(d) dma_rows256([&](int row) { return kbase + (size_t)row * 1024; }, 128, d)
#define RO_DMA_V(d, hf) dma_rows256([&](int row) { return vbase + (size_t)((hf) * 128 + row) * TS; }, 128, d)
#define RO_DMA_R(d, dir, hf) dma_rows256([&](int row) { return rbase + (size_t)(dir) * 32768 + (size_t)((hf) * 128 + row) * 128; }, 128, d)
  __syncthreads();
  RO_DMA_K(X);
  bf16x8 qf[4];
  {
    const u16* qrow = P.Qr + (size_t)(tok0 + i) * 1024 + h * 128 + q * 8;
#pragma unroll
    for (int kd = 0; kd < 4; ++kd) qf[kd] = *(const bf16x8*)(qrow + kd * 32);
  }
  const float xif = __builtin_amdgcn_exp2f(l2f * (float)(i + 1));
  const float xib = __builtin_amdgcn_exp2f(l2b * (float)(128 - i));
  DMA_WAIT_SYNC();
  RO_DMA_V(Y, 0);
  bf16x8 pf[4];
  {
    f32x4 sT[8];
#pragma unroll
    for (int jt = 0; jt < 8; ++jt) {
      sT[jt] = f32x4{0.f, 0.f, 0.f, 0.f};
#pragma unroll
      for (int kd = 0; kd < 4; ++kd) sT[jt] = MFMA(rd128(X, jt * 16 + l15, kd * 4 + q), qf[kd], sT[jt]);
    }
#pragma unroll
    for (int jt = 0; jt < 8; ++jt)
#pragma unroll
      for (int r = 0; r < 4; ++r) {
        int diff = i - (jt * 16 + q * 4 + r);
        float dcy = diff >= 0 ? __builtin_amdgcn_exp2f(l2f * (float)diff) : __builtin_amdgcn_exp2f(l2b * (float)(-diff));
        sT[jt][r] *= dcy;
      }
#pragma unroll
    for (int j2 = 0; j2 < 4; ++j2) {
      u32x4 pp;
      pp.x = pack2(sT[2 * j2][0], sT[2 * j2][1]);
      pp.y = pack2(sT[2 * j2][2], sT[2 * j2][3]);
      pp.z = pack2(sT[2 * j2 + 1][0], sT[2 * j2 + 1][1]);
      pp.w = pack2(sT[2 * j2 + 1][2], sT[2 * j2 + 1][3]);
      pf[j2] = __builtin_bit_cast(bf16x8, pp);
    }
  }
  f32x4 oT[8];
  u32x2 park[8];
  float ssum = 0.f, ssq = 0.f;
  DMA_WAIT_SYNC();
  RO_DMA_R(X, 0, 0);
  ro_pv(Y, pf, oT, l15, q);
  RO_WAIT_SYNC();
  RO_DMA_R(Y, 1, 0);
  ro_cross(X, xif, qf, oT, l15, q);
  RO_WAIT_SYNC();
  RO_DMA_V(X, 1);
  ro_cross(Y, xib, qf, oT, l15, q);
#pragma unroll
  for (int d = 0; d < 8; ++d) {
#pragma unroll
    for (int r = 0; r < 4; ++r) { float v = oT[d][r]; ssum += v; ssq += v * v; }
    park[d].x = pack2(oT[d][0], oT[d][1]);
    park[d].y = pack2(oT[d][2], oT[d][3]);
  }
  RO_WAIT_SYNC();
  RO_DMA_R(Y, 0, 1);
  ro_pv(X, pf, oT, l15, q);
  RO_WAIT_SYNC();
  RO_DMA_R(X, 1, 1);
  ro_cross(Y, xif, qf, oT, l15, q);
  RO_WAIT_SYNC();
  ro_cross(X, xib, qf, oT, l15, q);
#pragma unroll
  for (int d = 0; d < 8; ++d)
#pragma unroll
    for (int r = 0; r < 4; ++r) { float v = oT[d][r]; ssum += v; ssq += v * v; }
#undef RO_DMA_K
#undef RO_DMA_V
#undef RO_DMA_R
  ssum += __shfl_xor(ssum, 16); ssum += __shfl_xor(ssum, 32);
  ssq += __shfl_xor(ssq, 16); ssq += __shfl_xor(ssq, 32);
  const float mu = ssum * (1.f / 256.f);
  const float var = fmaxf(ssq * (1.f / 256.f) - mu * mu, 0.f);
  const float rs = rsqrtf(var + LN_EPS);
  const int tok = tok0 + i;
  const u16* grow = P.Rg + (size_t)tok * 2048 + h * 256 + q * 4;
  u16* orow = P.ret + (size_t)tok * 2048 + h * 256 + q * 4;
#pragma unroll
  for (int d = 0; d < 8; ++d) {
    {
      u32x2 pvv = park[d];
      uint2 g = *(const uint2*)(grow + d * 16);
      float g0 = bflo(g.x), g1 = bfhi(g.x), g2 = bflo(g.y), g3 = bfhi(g.y);
      uint2 o;
      o.x = pack2((bflo(pvv.x) - mu) * rs * g0 * sigm(g0), (bfhi(pvv.x) - mu) * rs * g1 * sigm(g1));
      o.y = pack2((bflo(pvv.y) - mu) * rs * g2 * sigm(g2), (bfhi(pvv.y) - mu) * rs * g3 * sigm(g3));
      *(uint2*)(orow + d * 16) = o;
    }
    {
      uint2 g = *(const uint2*)(grow + 128 + d * 16);
      float g0 = bflo(g.x), g1 = bfhi(g.x), g2 = bflo(g.y), g3 = bfhi(g.y);
      uint2 o;
      o.x = pack2((oT[d][0] - mu) * rs * g0 * sigm(g0), (oT[d][1] - mu) * rs * g1 * sigm(g1));
      o.y = pack2((oT[d][2] - mu) * rs * g2 * sigm(g2), (oT[d][3] - mu) * rs * g3 * sigm(g3));
      *(uint2*)(orow + 128 + d * 16) = o;
    }
  }
}

__device__ __forceinline__ void phase_att_merge(PREF P, int slab) {
  const int Sshift = slab < 2 ? 12 : 13;
  const int nitems = TS * 8 * 16;
  for (int idx = bid_() * NTHR + tid_(); idx < nitems; idx += gdim_() * NTHR) {
    const int d8 = idx & 15, hs = (idx >> 4) & 7, m = idx >> 7;
    int pg[3];
    float ls[3];
#pragma unroll
    for (int g = 0; g < 3; ++g) {
      pg[g] = posmap(m, Sshift, 2 * g);
      ls[g] = P.lse[((size_t)g * TS + pg[g]) * 8 + hs];
    }
    float mx = fmaxf(ls[0], fmaxf(ls[1], ls[2]));
    float e0 = __expf(ls[0] - mx), e1 = __expf(ls[1] - mx), e2 = __expf(ls[2] - mx);
    float inv = 1.f / (e0 + e1 + e2);
    float wg[3] = {e0 * inv, e1 * inv, e2 * inv};
    float a[8];
#pragma unroll
    for (int e = 0; e < 8; ++e) a[e] = 0.f;
#pragma unroll
    for (int g = 0; g < 3; ++g) {
      uint4 v = *(const uint4*)(P.og + ((size_t)g * TS + pg[g]) * 1024 + hs * 128 + d8 * 8);
      a[0] += wg[g] * bflo(v.x); a[1] += wg[g] * bfhi(v.x);
      a[2] += wg[g] * bflo(v.y); a[3] += wg[g] * bfhi(v.y);
      a[4] += wg[g] * bflo(v.z); a[5] += wg[g] * bfhi(v.z);
      a[6] += wg[g] * bflo(v.w); a[7] += wg[g] * bfhi(v.w);
    }
    uint4 o;
    o.x = pack2(a[0], a[1]); o.y = pack2(a[2], a[3]); o.z = pack2(a[4], a[5]); o.w = pack2(a[6], a[7]);
    *(uint4*)(P.att + (size_t)m * 1024 + hs * 128 + d8 * 8) = o;
  }
}

__device__ __forceinline__ void phase_gemm2(PREF P, char* smem) {
  const int lane = tid_() & 63, wid = tid_() >> 6, wm = wid >> 1, wn = wid & 1, l15 = lane & 15, q = lane >> 4;
  for (int t = bid_(); t < 64 * 16; t += gdim_()) {
    int mt, nt;
    tile_map(t, 2, mt, nt);
    const int m0 = mt * 128, n0 = nt * 128;
    f32x4 acc[4][4];
    gemm_core(P.ret, 2048, P.WretT, 2048, 2048, m0, n0, 13, 0, smem, acc);
#pragma unroll
    for (int i = 0; i < 4; ++i)
#pragma unroll
      for (int j = 0; j < 4; ++j) {
        const int row = m0 + wm * 64 + i * 16 + l15, col = n0 + (j & 1) * 16 + wn * 32 + (j >> 1) * 64 + q * 4;
        const unsigned g = *(const unsigned*)((const u8*)P.GA + (size_t)row * 2048 + col);
        f32x4 v;
        v[0] = (float)(g & 255u) * (1.f / 255.f) * acc[i][j][0]; v[1] = (float)((g >> 8) & 255u) * (1.f / 255.f) * acc[i][j][1];
        v[2] = (float)((g >> 16) & 255u) * (1.f / 255.f) * acc[i][j][2]; v[3] = (float)(g >> 24) * (1.f / 255.f) * acc[i][j][3];
        store_nat(P.merged, 2048, row, col, v);
      }
    gemm_core(P.att, 1024, P.WattT, 1024, 1024, m0, n0, 13, 0, smem, acc);
#pragma unroll
    for (int i = 0; i < 4; ++i)
#pragma unroll
      for (int j = 0; j < 4; ++j) {
        const int row = m0 + wm * 64 + i * 16 + l15, col = n0 + (j & 1) * 16 + wn * 32 + (j >> 1) * 64 + q * 4;
        const unsigned g = *(const unsigned*)((const u8*)P.GB + (size_t)row * 2048 + col);
        uint2 pr = *(const uint2*)(P.merged + (size_t)row * 2048 + col);
        f32x4 v;
        v[0] = bflo(pr.x) + (float)(g & 255u) * (1.f / 255.f) * acc[i][j][0];
        v[1] = bfhi(pr.x) + (float)((g >> 8) & 255u) * (1.f / 255.f) * acc[i][j][1];
        v[2] = bflo(pr.y) + (float)((g >> 16) & 255u) * (1.f / 255.f) * acc[i][j][2];
        v[3] = bfhi(pr.y) + (float)(g >> 24) * (1.f / 255.f) * acc[i][j][3];
        acc[i][j] = v;
      }
    stage_tile_bf16(smem, acc, P.merged, 2048, m0, n0);
  }
}

__device__ __forceinline__ void phase_gemm3(PREF P, int slab, char* smem) {
  const int lane = tid_() & 63, wid = tid_() >> 6, wm = wid >> 1, wn = wid & 1, l15 = lane & 15, q = lane >> 4;
  const float* xs = x_slab(P, slab);
  for (int t = bid_(); t < 64 * 16; t += gdim_()) {
    int mt, nt;
    tile_map(t, 2, mt, nt);
    const int m0 = mt * 128, n0 = nt * 128;
    f32x4 acc[4][4];
    gemm_core(P.merged, 2048, P.WoutT, 2048, 2048, m0, n0, 13, 0, smem, acc);
#pragma unroll
    for (int i = 0; i < 4; ++i)
#pragma unroll
      for (int j = 0; j < 4; ++j) {
        const int row = m0 + wm * 64 + i * 16 + l15, col = n0 + (j & 1) * 16 + wn * 32 + (j >> 1) * 64 + q * 4;
        float4 xv = *(const float4*)(xs + (size_t)row * 2048 + col);
        f32x4 o;
        o[0] = DN_ALPHA * xv.x + acc[i][j][0]; o[1] = DN_ALPHA * xv.y + acc[i][j][1];
        o[2] = DN_ALPHA * xv.z + acc[i][j][2]; o[3] = DN_ALPHA * xv.w + acc[i][j][3];
        acc[i][j] = o;
      }
    stage_tile_bf16(smem, acc, (u16*)P.y, 2048, m0, n0);
  }
}

__device__ __forceinline__ void phase_ln1(PREF P) {
  const int lane = tid_() & 63, wid = tid_() >> 6;
  for (int t = bid_() * 4 + wid; t < TS; t += gdim_() * 4) {
    const u16* yr = (const u16*)P.y + (size_t)t * 2048;
    float v[32];
#pragma unroll
    for (int u = 0; u < 4; ++u) {
      u32x4 a = *(const u32x4*)(yr + u * 512 + lane * 8);
      v[u * 8 + 0] = bflo(a.x); v[u * 8 + 1] = bfhi(a.x); v[u * 8 + 2] = bflo(a.y); v[u * 8 + 3] = bfhi(a.y);
      v[u * 8 + 4] = bflo(a.z); v[u * 8 + 5] = bfhi(a.z); v[u * 8 + 6] = bflo(a.w); v[u * 8 + 7] = bfhi(a.w);
    }
    float s = 0.f;
#pragma unroll
    for (int e = 0; e < 32; ++e) s += v[e];
    const float mu = wsum(s) * (1.f / 2048.f);
    float vs = 0.f;
#pragma unroll
    for (int e = 0; e < 32; ++e) { float d = v[e] - mu; vs += d * d; }
    const float rs = rsqrtf(wsum(vs) * (1.f / 2048.f) + LN_EPS);
#pragma unroll
    for (int u = 0; u < 4; ++u) {
      const int c = u * 512 + lane * 8;
      float4 g0 = *(const float4*)(P.ln1_g + c), g1 = *(const float4*)(P.ln1_g + c + 4);
      float4 b0 = *(const float4*)(P.ln1_b + c), b1 = *(const float4*)(P.ln1_b + c + 4);
      uint4 o;
      o.x = pack2((v[u * 8 + 0] - mu) * rs * g0.x + b0.x, (v[u * 8 + 1] - mu) * rs * g0.y + b0.y);
      o.y = pack2((v[u * 8 + 2] - mu) * rs * g0.z + b0.z, (v[u * 8 + 3] - mu) * rs * g0.w + b0.w);
      o.z = pack2((v[u * 8 + 4] - mu) * rs * g1.x + b1.x, (v[u * 8 + 5] - mu) * rs * g1.y + b1.y);
      o.w = pack2((v[u * 8 + 6] - mu) * rs * g1.z + b1.z, (v[u * 8 + 7] - mu) * rs * g1.w + b1.w);
      *(uint4*)(P.hb + (size_t)t * 2048 + c) = o;
    }
    float am = 0.f;
#pragma unroll
    for (int u = 0; u < 4; ++u) {
      const int c = u * 512 + lane * 8;
      float4 g0 = *(const float4*)(P.ln1_g + c), g1 = *(const float4*)(P.ln1_g + c + 4);
      float4 b0 = *(const float4*)(P.ln1_b + c), b1 = *(const float4*)(P.ln1_b + c + 4);
      v[u * 8 + 0] = (v[u * 8 + 0] - mu) * rs * g0.x + b0.x; v[u * 8 + 1] = (v[u * 8 + 1] - mu) * rs * g0.y + b0.y;
      v[u * 8 + 2] = (v[u * 8 + 2] - mu) * rs * g0.z + b0.z; v[u * 8 + 3] = (v[u * 8 + 3] - mu) * rs * g0.w + b0.w;
      v[u * 8 + 4] = (v[u * 8 + 4] - mu) * rs * g1.x + b1.x; v[u * 8 + 5] = (v[u * 8 + 5] - mu) * rs * g1.y + b1.y;
      v[u * 8 + 6] = (v[u * 8 + 6] - mu) * rs * g1.z + b1.z; v[u * 8 + 7] = (v[u * 8 + 7] - mu) * rs * g1.w + b1.w;
    }
#pragma unroll
    for (int e = 0; e < 32; ++e) am = fmaxf(am, fabsf(v[e]));
    am = wmax(am);
    const float sc = am > 0.f ? am * (1.f / 127.f) : 1.f;
    const float inv = 1.f / sc;
#pragma unroll
    for (int u = 0; u < 4; ++u) {
      u32x2 o;
      o.x = q4(v[u * 8 + 0], v[u * 8 + 1], v[u * 8 + 2], v[u * 8 + 3], inv, 0);
      o.y = q4(v[u * 8 + 4], v[u * 8 + 5], v[u * 8 + 6], v[u * 8 + 7], inv, 0);
      *(u32x2*)(P.h8 + (size_t)t * 2048 + u * 512 + lane * 8) = o;
    }
    if (lane == 0) P.sh[t] = sc;
  }
}

__device__ __forceinline__ void phase_gemm45(PREF P, char* smem, int which) {
  const int lane = tid_() & 63, wid = tid_() >> 6, wm = wid >> 1, wn = wid & 1, l15 = lane & 15, q = lane >> 4;
  for (int t = bid_(); t < 64 * 16; t += gdim_()) {
    int mt, nt;
    tile_map(t, 2, mt, nt);
    const int m0 = mt * 128, n0 = nt * 128;
    f32x4 acc[4][4];
    if (!which) {
      i32x4 iacc[4][4];
      gemm_core_i8(P.h8, 2048, P.Wq8, 2048, 2048, m0, n0, 13, 0, smem, iacc);
#pragma unroll
      for (int i = 0; i < 4; ++i) {
        const int row = m0 + wm * 64 + i * 16 + l15;
        const float shr = P.sh[row];
#pragma unroll
        for (int j = 0; j < 4; ++j) {
          const int col = n0 + (j & 1) * 16 + wn * 32 + (j >> 1) * 64 + q * 4;
          const float4 swc = *(const float4*)(P.swq + col);
          f32x4 v;
          v[0] = (float)iacc[i][j][0] * shr * swc.x; v[1] = (float)iacc[i][j][1] * shr * swc.y;
          v[2] = (float)iacc[i][j][2] * shr * swc.z; v[3] = (float)iacc[i][j][3] * shr * swc.w;
          acc[i][j] = v;
        }
      }
      stage_tile_bf16(smem, acc, P.qb, 2048, m0, n0);
    } else {
      unsigned part[4][4][2];
      {
        i32x4 iacc[4][4];
        gemm_core_i8(P.h8, 2048, P.Wpg8, 2048, 2048, m0, n0, 13, 0, smem, iacc);
#pragma unroll
        for (int i = 0; i < 4; ++i) {
          const int row = m0 + wm * 64 + i * 16 + l15;
          const float shr = P.sh[row];
#pragma unroll
          for (int j = 0; j < 4; ++j) {
            const int col = n0 + (j & 1) * 16 + wn * 32 + (j >> 1) * 64 + q * 4;
            const float4 swc = *(const float4*)(P.swpg + col);
            part[i][j][0] = pack2(sigm((float)iacc[i][j][0] * shr * swc.x), sigm((float)iacc[i][j][1] * shr * swc.y));
            part[i][j][1] = pack2(sigm((float)iacc[i][j][2] * shr * swc.z), sigm((float)iacc[i][j][3] * shr * swc.w));
          }
        }
      }
      gemm_core(P.pb, 256, P.WpeT, 256, 256, m0, n0, 13, 0, smem, acc);
#pragma unroll
      for (int i = 0; i < 4; ++i)
#pragma unroll
        for (int j = 0; j < 4; ++j) {
          const int row = m0 + wm * 64 + i * 16 + l15, col = n0 + (j & 1) * 16 + wn * 32 + (j >> 1) * 64 + q * 4;
          f32x4 v;
          v[0] = bflo(part[i][j][0]) * acc[i][j][0]; v[1] = bfhi(part[i][j][0]) * acc[i][j][1];
          v[2] = bflo(part[i][j][1]) * acc[i][j][2]; v[3] = bfhi(part[i][j][1]) * acc[i][j][3];
          acc[i][j] = v;
        }
      stage_tile_bf16(smem, acc, P.peb, 2048, m0, n0);
    }
  }
}

DEV void ce_insert(float (&top)[16], float x) {
#pragma unroll
  for (int p = 0; p < 16; ++p) {
    float hi = fmaxf(top[p], x), lo = fminf(top[p], x);
    top[p] = hi; x = lo;
  }
}

__device__ __forceinline__ void peer_topk_item(PREF P, int w, char* smem) {
  float* Ls = (float*)smem;
  float* Ll = (float*)(smem + 2 * 64 * 129 * 4);
  const int tid = tid_(), lane = tid & 63, wid = tid >> 6, l15 = lane & 15, q = lane >> 4;
  const int tb = w >> 3, h = w & 7, t0 = tb * 64;
  __syncthreads();
  {
    const int c = wid >> 1, th = wid & 1;
    f32x4 acc[8][2];
#pragma unroll
    for (int a = 0; a < 8; ++a) { acc[a][0] = f32x4{0.f, 0.f, 0.f, 0.f}; acc[a][1] = f32x4{0.f, 0.f, 0.f, 0.f}; }
#pragma unroll
    for (int kd = 0; kd < 4; ++kd) {
      bf16x8 qf[2];
#pragma unroll
      for (int tt = 0; tt < 2; ++tt)
        qf[tt] = *(const bf16x8*)(P.qb + (size_t)(t0 + th * 32 + tt * 16 + l15) * 2048 + h * 256 + c * 128 + kd * 32 + q * 8);
#pragma unroll
      for (int kt = 0; kt < 8; ++kt) {
        bf16x8 kf = *(const bf16x8*)(P.keysb + (size_t)((h * 2 + c) * 128 + kt * 16 + l15) * 128 + kd * 32 + q * 8);
        acc[kt][0] = MFMA(kf, qf[0], acc[kt][0]);
        acc[kt][1] = MFMA(kf, qf[1], acc[kt][1]);
      }
    }
#pragma unroll
    for (int kt = 0; kt < 8; ++kt)
#pragma unroll
      for (int tt = 0; tt < 2; ++tt)
#pragma unroll
        for (int r = 0; r < 4; ++r) Ls[(c * 64 + th * 32 + tt * 16 + l15) * 129 + kt * 16 + q * 4 + r] = acc[kt][tt][r];
  }
  __syncthreads();
  {
    const int row = tid & 127, half = tid >> 7;
    float top[16];
#pragma unroll
    for (int k = 0; k < 16; ++k) top[k] = -3.0e38f;
    const float* src = Ls + row * 129 + half * 64;
#pragma unroll 4
    for (int k = 0; k < 64; ++k) {
      float x = __uint_as_float((__float_as_uint(src[k]) & ~127u) | (unsigned)(half * 64 + k));
      ce_insert(top, x);
    }
    if (half == 1) {
#pragma unroll
      for (int k = 0; k < 16; ++k) Ll[row * 17 + k] = top[k];
    }
    __syncthreads();
    if (half == 0) {
#pragma unroll
      for (int k = 0; k < 16; ++k) ce_insert(top, Ll[row * 17 + k]);
    }
    __syncthreads();
    if (half == 0) {
#pragma unroll
      for (int k = 0; k < 16; ++k) Ll[row * 17 + k] = top[k];
    }
    __syncthreads();
  }
  if (tid < 64) {
    const int t = tid;
    float a[16], b[16];
#pragma unroll
    for (int k = 0; k < 16; ++k) {
      a[k] = __uint_as_float(__float_as_uint(Ll[t * 17 + k]) & ~127u);
      b[k] = __uint_as_float(__float_as_uint(Ll[(64 + t) * 17 + k]) & ~127u);
    }
    float top[16];
#pragma unroll
    for (int k = 0; k < 16; ++k) top[k] = -3.0e38f;
#pragma unroll
    for (int i = 0; i < 16; ++i)
#pragma unroll
      for (int j = 0; j < 16; ++j)
        if ((i + 1) * (j + 1) <= 16) {
          float s = a[i] + b[j];
          s = __uint_as_float((__float_as_uint(s) & ~255u) | (unsigned)(i * 16 + j));
          ce_insert(top, s);
        }
    const float best0 = __uint_as_float(__float_as_uint(top[0]) & ~255u);
    float ev[16], sum = 0.f;
#pragma unroll
    for (int k = 0; k < 16; ++k) {
      float bk = __uint_as_float(__float_as_uint(top[k]) & ~255u);
      ev[k] = __expf(bk - best0);
      sum += ev[k];
    }
    const float inv = 1.f / sum;
#pragma unroll
    for (int k = 0; k < 16; ++k) {
      unsigned code = __float_as_uint(top[k]) & 255u;
      int ia = __float_as_uint(Ll[t * 17 + (code >> 4)]) & 127u;
      int ib = __float_as_uint(Ll[(64 + t) * 17 + (code & 15u)]) & 127u;
      P.eidx[(size_t)(t0 + t) * 128 + h * 16 + k] = ia * 128 + ib;
      P.gw[(size_t)(t0 + t) * 128 + h * 16 + k] = ev[k] * inv;
    }
  }
}

DEV float gelu_exact(float x) { return 0.5f * x * (1.f + erff(x * 0.70710678118654752f)); }
DEV void axpy_ub(float* acc, float c, unsigned w) {
  acc[0] += c * (float)(w & 0xffu); acc[1] += c * (float)((w >> 8) & 0xffu);
  acc[2] += c * (float)((w >> 16) & 0xffu); acc[3] += c * (float)(w >> 24);
}
DEV void ld16bf(const u16* p, float* o) {
  u32x4 a = *(const u32x4*)p, b = *(const u32x4*)(p + 8);
  o[0] = bflo(a.x); o[1] = bfhi(a.x); o[2] = bflo(a.y); o[3] = bfhi(a.y);
  o[4] = bflo(a.z); o[5] = bfhi(a.z); o[6] = bflo(a.w); o[7] = bfhi(a.w);
  o[8] = bflo(b.x); o[9] = bfhi(b.x); o[10] = bflo(b.y); o[11] = bfhi(b.y);
  o[12] = bflo(b.z); o[13] = bfhi(b.z); o[14] = bflo(b.w); o[15] = bfhi(b.w);
}

__device__ __forceinline__ void phase_peer_gather(PREF P, int slab, int tbeg, int tend) {
  const int lane = tid_() & 63, wid = tid_() >> 6;
  float* outs = P.out + (size_t)slab * TS * DM;
  typedef const __attribute__((address_space(1))) unsigned char* gbytes_t;
  gbytes_t U8 = (gbytes_t)P.Ub;
  gbytes_t V8 = (gbytes_t)P.Vb;
  for (int t = tbeg + bid_() * 4 + wid; t < tend; t += gdim_() * 4) {
    const u16* hrow = P.hb + (size_t)t * 2048 + lane * 16;
    int xq[8];
    float sh;
    {
      float hv[32];
      ld16bf(hrow, hv);
      ld16bf(hrow + 1024, hv + 16);
      float am = 0.f;
#pragma unroll
      for (int e = 0; e < 32; ++e) am = fmaxf(am, fabsf(hv[e]));
      am = wmax(am);
      sh = am > 0.f ? am * (1.f / 127.f) : 1.f;
      const float inv = 1.f / sh;
#pragma unroll
      for (int w = 0; w < 8; ++w) xq[w] = (int)q4(hv[w * 4], hv[w * 4 + 1], hv[w * 4 + 2], hv[w * 4 + 3], inv, 0);
    }
    float acc[32];
#pragma unroll
    for (int e = 0; e < 32; ++e) acc[e] = 0.f;
    float csum = 0.f;
#pragma unroll 1
    for (int half = 0; half < 2; ++half) {
      const int ev = P.eidx[(size_t)t * 128 + half * 64 + lane];
      const int gv = __float_as_int(P.gw[(size_t)t * 128 + half * 64 + lane]);
      const int suv = __float_as_int(P.su[ev]);
      const int svv = __float_as_int(P.sv[ev]);
#pragma unroll 1
      for (int e = 0; e < 64; e += 4) {
        u32x4 ua[4][2], va[4][2];
        float cg[4], csu[4], csv[4];
#pragma unroll
        for (int k = 0; k < 4; ++k) {
          const int ix = __builtin_amdgcn_readlane(ev, e + k);
          cg[k] = __int_as_float(__builtin_amdgcn_readlane(gv, e + k));
          csu[k] = __int_as_float(__builtin_amdgcn_readlane(suv, e + k));
          csv[k] = __int_as_float(__builtin_amdgcn_readlane(svv, e + k));
          typedef const __attribute__((address_space(1))) u32x4* gvec_t;
          gbytes_t up = U8 + (size_t)ix * 2048 + lane * 16;
          gbytes_t vp = V8 + (size_t)ix * 2048 + lane * 16;
          ua[k][0] = *(gvec_t)up; ua[k][1] = *(gvec_t)(up + 1024);
          va[k][0] = *(gvec_t)vp; va[k][1] = *(gvec_t)(vp + 1024);
        }
        int id[4];
#pragma unroll
        for (int k = 0; k < 4; ++k) {
          int d = 0;
          d = __builtin_amdgcn_sdot4((int)ua[k][0].x, xq[0], d, false); d = __builtin_amdgcn_sdot4((int)ua[k][0].y, xq[1], d, false);
          d = __builtin_amdgcn_sdot4((int)ua[k][0].z, xq[2], d, false); d = __builtin_amdgcn_sdot4((int)ua[k][0].w, xq[3], d, false);
          d = __builtin_amdgcn_sdot4((int)ua[k][1].x, xq[4], d, false); d = __builtin_amdgcn_sdot4((int)ua[k][1].y, xq[5], d, false);
          d = __builtin_amdgcn_sdot4((int)ua[k][1].z, xq[6], d, false); d = __builtin_amdgcn_sdot4((int)ua[k][1].w, xq[7], d, false);
          id[k] = d;
        }
#pragma unroll
        for (int k = 0; k < 4; ++k) id[k] = wsum_i(id[k]);
#pragma unroll
        for (int k = 0; k < 4; ++k) {
          const float d = (float)id[k] * csu[k] * sh;
          const float c = cg[k] * gelu_exact(d) * csv[k];
          csum += c;
          axpy_ub(acc + 0, c, va[k][0].x);  axpy_ub(acc + 4, c, va[k][0].y);
          axpy_ub(acc + 8, c, va[k][0].z);  axpy_ub(acc + 12, c, va[k][0].w);
          axpy_ub(acc + 16, c, va[k][1].x); axpy_ub(acc + 20, c, va[k][1].y);
          axpy_ub(acc + 24, c, va[k][1].z); axpy_ub(acc + 28, c, va[k][1].w);
        }
      }
    }
    {
      const float corr = 128.f * csum;
      float hv[16], pv[16];
#pragma unroll
      for (int hf = 0; hf < 2; ++hf) {
        ld16bf(hrow + hf * 1024, hv);
        ld16bf(P.peb + (size_t)t * 2048 + lane * 16 + hf * 1024, pv);
#pragma unroll
        for (int e = 0; e < 16; ++e) acc[hf * 16 + e] = acc[hf * 16 + e] - corr + DN_ALPHA * hv[e] + pv[e];
      }
    }
    float s = 0.f;
#pragma unroll
    for (int e = 0; e < 32; ++e) s += acc[e];
    const float mu = wsum(s) * (1.f / 2048.f);
    float vs = 0.f;
#pragma unroll
    for (int e = 0; e < 32; ++e) { float d = acc[e] - mu; vs += d * d; }
    const float rs = rsqrtf(wsum(vs) * (1.f / 2048.f) + LN_EPS);
    float* orow = outs + (size_t)t * 2048;
#pragma unroll
    for (int hf = 0; hf < 2; ++hf)
#pragma unroll
      for (int c4 = 0; c4 < 4; ++c4) {
        const int c = hf * 1024 + lane * 16 + c4 * 4;
        float4 g = *(const float4*)(P.ln2_g + c), b = *(const float4*)(P.ln2_b + c);
        float4 o;
        o.x = (acc[hf * 16 + c4 * 4 + 0] - mu) * rs * g.x + b.x;
        o.y = (acc[hf * 16 + c4 * 4 + 1] - mu) * rs * g.y + b.y;
        o.z = (acc[hf * 16 + c4 * 4 + 2] - mu) * rs * g.z + b.z;
        o.w = (acc[hf * 16 + c4 * 4 + 3] - mu) * rs * g.w + b.w;
        *(float4*)(orow + c) = o;
      }
  }
}

__device__ void build_bias_table(PREF P) {
  const int gtid = bid_() * NTHR + tid_();
  if (gtid < 24 * 129) {
    const int o = gtid % 129, gh = gtid / 129, gi = gh >> 3;
    const int rel = (o - 64) << (2 * gi);
    int ret = rel > 0 ? 16 : 0;
    int n = rel < 0 ? -rel : rel;
    int bucket;
    if (n < 8) bucket = n;
    else {
      int large = 8 + (int)(logf((float)n / 8.f) / 4.852030263919617f * 8.f);
      bucket = large < 15 ? large : 15;
    }
    P.biasT[gtid] = P.rel_bias[(ret + bucket) * 24 + gh];
  }
}

#define XB_TMO      128
#define XB_XCNT(j)  (256  + 64 * (j))
#define XB_XSUB(j)  (1280 + 64 * (j))
#define XB_XGEN(j)  (2304 + 64 * (j))
#define XB_TOP      3328
#define XB_TOPGEN   3392
#define XCD_BAR_WORDS 3456
#define CU_CENSUS_BASE 3584
#define BAR_TOTAL_WORDS (3584 + 4096)
#define XB_SPIN_CAP (1u << 20)
#define LAS __attribute__((address_space(3)))
DEV unsigned xb_ld(unsigned* p) { return __hip_atomic_load(p, __ATOMIC_RELAXED, __HIP_MEMORY_SCOPE_AGENT); }
DEV unsigned xb_add(unsigned* p, unsigned v) { return __hip_atomic_fetch_add(p, v, __ATOMIC_RELAXED, __HIP_MEMORY_SCOPE_AGENT); }
DEV unsigned xb_xcc_id() { return (unsigned)__builtin_amdgcn_s_getreg((3 << 11) | 20) & 0xFu; }
#define XB_SPIN(cond, bar) do { unsigned _sp = 0; while (cond) { __builtin_amdgcn_s_sleep(1); \
    if ((++_sp & 255u) == 0u) { if (xb_ld(&(bar)[XB_TMO])) break; if (_sp > XB_SPIN_CAP) { atomicAdd(&(bar)[XB_TMO], 1u); break; } } } } while (0)
struct XcdBarrier { unsigned* bar; unsigned x; volatile LAS unsigned* st; };
DEV XcdBarrier xcd_barrier_post(unsigned* bar, volatile LAS unsigned* st) {
  XcdBarrier b; b.bar = bar; b.x = xb_xcc_id(); b.st = st;
  if (threadIdx.x == 0) (void)xb_add(&bar[XB_XCNT(b.x)], 1u);
  return b;
}
DEV void xcd_barrier_complete(unsigned* bar, unsigned x, unsigned& nloc, unsigned& nx) {
  const unsigned G = gridDim.x * gridDim.y * gridDim.z;
  unsigned sum, cnt, mine, sp = 0u;
  for (;;) {
    sum = 0u; cnt = 0u; mine = 0u;
#pragma unroll
    for (unsigned j = 0; j < 16; ++j) { const unsigned c = xb_ld(&bar[XB_XCNT(j)]); sum += c; cnt += (c > 0u) ? 1u : 0u; mine = (j == x) ? c : mine; }
    if (sum == G) break;
    __builtin_amdgcn_s_sleep(1);
    if ((++sp & 255u) == 0u) { if (xb_ld(&bar[XB_TMO])) break; if (sp > XB_SPIN_CAP) { atomicAdd(&bar[XB_TMO], 1u); break; } }
  }
  nloc = mine > 0u ? mine : 1u; nx = cnt > 0u ? cnt : 1u;
}
DEV void xcd_barrier(const XcdBarrier& b) {
  asm volatile("s_waitcnt vmcnt(0)" ::: "memory");
  __syncthreads();
  if (threadIdx.x == 0) {
    unsigned* bar = b.bar;
    __builtin_amdgcn_s_waitcnt(0);
    unsigned nloc = b.st[0], nx = b.st[1];
    if (nloc == 0u) { xcd_barrier_complete(bar, b.x, nloc, nx); b.st[0] = nloc; b.st[1] = nx; }
    const unsigned old = xb_add(&bar[XB_XSUB(b.x)], 1u);
    const unsigned gen = old / nloc;
    if (old + 1u == (gen + 1u) * nloc) {
      __builtin_amdgcn_fence(__ATOMIC_RELEASE, "agent");
      asm volatile("s_waitcnt vmcnt(0)" ::: "memory");
      const unsigned og = xb_add(&bar[XB_TOP], 1u);
      const unsigned tg = og / nx;
      if (og + 1u == (tg + 1u) * nx) xb_add(&bar[XB_TOPGEN], 1u);
      else XB_SPIN(xb_ld(&bar[XB_TOPGEN]) == tg, bar);
      __builtin_amdgcn_fence(__ATOMIC_ACQUIRE, "agent");
      xb_add(&bar[XB_XGEN(b.x)], 1u);
      asm volatile("s_waitcnt vmcnt(0)" ::: "memory");
    } else {
      XB_SPIN(xb_ld(&bar[XB_XGEN(b.x)]) == gen, bar);
      __builtin_amdgcn_fence(__ATOMIC_ACQUIRE, "agent");
      asm volatile("s_waitcnt vmcnt(0)" ::: "memory");
    }
  }
  __syncthreads();
}

#ifndef REPA
#define REPA 1
#endif
#ifndef REPB
#define REPB 1
#endif
#ifndef REPD
#define REPD 1
#endif
#ifndef REPE
#define REPE 1
#endif
#ifndef REPI
#define REPI 1
#endif
#ifndef REPJ
#define REPJ 1
#endif
#ifndef REPS
#define REPS 1
#endif
__global__ void __launch_bounds__(NTHR, 2) fwd_megakernel(Params Pk) {
  __shared__ __attribute__((aligned(16))) char smem[SMEM_BYTES];
  __shared__ Params sP;
  cg::grid_group grid = cg::this_grid();
  {
    const unsigned* srcw = (const unsigned*)&Pk;
    unsigned* dstw = (unsigned*)&sP;
    for (int i = tid_(); i < (int)(sizeof(Params) / 4); i += NTHR) dstw[i] = srcw[i];
  }
  __shared__ uint4 xb_words;
  __shared__ unsigned cu_slot_s;
  if (threadIdx.x == 0) xb_words = make_uint4(0u, 0u, 0u, 0u);
  __syncthreads();
  LParams* lp = (LParams*)&sP;
#define P (*launderP(lp))
  const XcdBarrier xb = xcd_barrier_post(Pk.bar, (volatile LAS unsigned*)&xb_words);
  if (threadIdx.x == 0) {
    const unsigned hwid = (unsigned)__builtin_amdgcn_s_getreg((31 << 11) | 4);
    const unsigned key = (xb.x & 15u) * 256u + ((hwid >> 8) & 127u);
    cu_slot_s = xb_add(&Pk.bar[CU_CENSUS_BASE + key], 1u);
  }
  __syncthreads();
  const int cu_slot = (int)(blockIdx.x & 1u);
#define GSYNC() xcd_barrier(xb)

  transpose_convert(P.w_in, 2048, 19456, P.WinTtmp, smem);
  transpose_convert(P.w_ret_o, 2048, 2048, P.WretT, smem);
  transpose_convert(P.w_att_o, 1024, 2048, P.WattT, smem);
  transpose_convert(P.w_out, 2048, 2048, P.WoutT, smem);
  transpose_convert(P.peer_wq, 2048, 2048, P.WqTtmp, smem);
  transpose_convert(P.w_pg, 2048, 2048, P.WpgTtmp, smem);
  transpose_convert(P.w_pe, 256, 2048, P.WpeT, smem);
  convert_bf16(P.peer_keys, P.keysb, 262144 / 8);
  quant_rows_f32(P.peer_u, (unsigned char*)P.Ub, P.su, 16384, 0);
  quant_rows_f32(P.peer_v, (unsigned char*)P.Vb, P.sv, 16384, 128);
  quant_rows_f32(x_slab(P, 0), P.xq8, P.sx, TS, 0);
  build_bias_table(P);
  grid.sync();
  quant_rows_bf16(P.WinTtmp, P.Win8, P.sw, 19456);
  quant_rows_bf16(P.WpgTtmp, P.Wpg8, P.swpg, 2048);
  quant_rows_bf16(P.WqTtmp, P.Wq8, P.swq, 2048);
  GSYNC();

#pragma unroll 1
  for (int slab = -1; slab < 4; ++slab) {
    if (slab >= 0) {
      const int Sshift = slab < 2 ? 12 : 13;
      u16* ST = (u16*)(P.out + (size_t)slab * TS * DM);
#pragma unroll 1
      for (int part = 0; part < 2; ++part) {
        if (part == cu_slot) {
          for (int w = bid_(); w < 1024 + 3072; w += gdim_()) {
            if (w < 1024) ret_kv_item(P, w, ST, smem);
            else attn_item(P, w - 1024, Sshift, smem);
          }
        } else if (slab >= 1) {
          phase_peer_gather(P, slab - 1, JSPLIT, TS);
        }
      }
      GSYNC();
      phase_scan(P, slab, ST);
      if (slab + 1 < 4) quant_rows_f32(x_slab(P, slab + 1), P.xq8, P.sx, TS, 0);
      convert_bf16(p_slab(P, slab), P.pb, (size_t)TS * 256 / 8);
      phase_att_merge(P, slab);
      GSYNC();
      for (int w = bid_(); w < 1024; w += gdim_()) ret_out_item(P, w, ST, smem);
      GSYNC();
      phase_gemm2(P, smem);
      GSYNC();
      phase_gemm3(P, slab, smem);
      GSYNC();
      phase_ln1(P);
      GSYNC();
      phase_gemm45(P, smem, 0);
      GSYNC();
#pragma unroll 1
      for (int part = 0; part < 2; ++part) {
        if (part == cu_slot) phase_gemm45(P, smem, 1);
        else for (int w = bid_(); w < 1024; w += gdim_()) peer_topk_item(P, w, smem);
      }
      GSYNC();
    }
#pragma unroll 1
    for (int part = 0; part < 2; ++part) {
      if (part == cu_slot) { if (slab + 1 < 4) phase_gemm1(P, slab + 1, smem); }
      else { if (slab >= 0) phase_peer_gather(P, slab, 0, slab + 1 < 4 ? JSPLIT : TS); }
    }
    GSYNC();
  }
}

#undef P
#undef GSYNC
extern "C" void kernel_launch(void* const* d_in, const int* in_sizes, int n_in, void* d_out, int out_size, void* d_ws,
                              size_t ws_size, hipStream_t stream) {
  Params P;
  std::memset((void*)&P, 0, sizeof(P));
  P.x_prompt = (const float*)d_in[0];  P.x_sample = (const float*)d_in[1];
  P.p_prompt = (const float*)d_in[2];  P.p_sample = (const float*)d_in[3];
  P.w_in = (const float*)d_in[4];      P.decay_logit = (const float*)d_in[5];
  P.w_ret_o = (const float*)d_in[6];   P.w_att_o = (const float*)d_in[7];
  P.w_out = (const float*)d_in[8];     P.rel_bias = (const float*)d_in[9];
  P.ln1_g = (const float*)d_in[10];    P.ln1_b = (const float*)d_in[11];
  P.peer_wq = (const float*)d_in[12];  P.peer_keys = (const float*)d_in[13];
  P.peer_u = (const float*)d_in[14];   P.peer_v = (const float*)d_in[15];
  P.w_pe = (const float*)d_in[16];     P.w_pg = (const float*)d_in[17];
  P.ln2_g = (const float*)d_in[18];    P.ln2_b = (const float*)d_in[19];
  P.out = (float*)d_out;

  char* base = (char*)d_ws;
  size_t off = 0;
  auto take = [&](size_t bytes) { char* p = base + off; off += (bytes + 255) & ~(size_t)255; return p; };
  P.Win8 = (u8*)take((size_t)19456 * 2048);
  P.sw = (float*)take((size_t)19456 * 4);
  P.WretT = (u16*)take((size_t)2048 * 2048 * 2);
  P.WattT = (u16*)take((size_t)2048 * 1024 * 2);
  P.WoutT = (u16*)take((size_t)2048 * 2048 * 2);
  P.Wq8 = (u8*)take((size_t)2048 * 2048);
  P.swq = (float*)take((size_t)2048 * 4);
  P.Wpg8 = (u8*)take((size_t)2048 * 2048);
  P.swpg = (float*)take((size_t)2048 * 4);
  P.WpeT = (u16*)take((size_t)2048 * 256 * 2);
  P.keysb = (u16*)take((size_t)262144 * 2);
  P.Ub = (u16*)take((size_t)16384 * 2048);
  P.Vb = (u16*)take((size_t)16384 * 2048);
  P.su = (float*)take((size_t)16384 * 4);
  P.sv = (float*)take((size_t)16384 * 4);
  P.xq8 = (u8*)take((size_t)TS * 2048);
  P.sx = (float*)take((size_t)TS * 4);
  P.h8 = (u8*)take((size_t)TS * 2048);
  P.sh = (float*)take((size_t)TS * 4);
  P.pb = (u16*)take((size_t)TS * 256 * 2);
  P.Qr = (u16*)take((size_t)TS * 1024 * 2);
  P.Kr = (u16*)take((size_t)TS * 1024 * 2);
  P.KrT = (u16*)take((size_t)TS * 1024 * 2);
  P.VrT = (u16*)take((size_t)TS * 2048 * 2);
  P.Rg = (u16*)take((size_t)TS * 2048 * 2);
  P.AQ = (u16*)take((size_t)TS * 3072 * 2);
  P.AK = (u16*)take((size_t)TS * 3072 * 2);
  P.AVT = (u16*)take((size_t)TS * 3072 * 2);
  P.GA = (u16*)take((size_t)TS * 2048 * 2);
  P.GB = (u16*)take((size_t)TS * 2048 * 2);
  P.og = (u16*)take((size_t)3 * TS * 1024 * 2);
  P.lse = (float*)take((size_t)3 * TS * 8 * 4);
  P.ret = (u16*)take((size_t)TS * 2048 * 2);
  P.att = (u16*)take((size_t)TS * 1024 * 2);
  P.eidx = (int*)take((size_t)TS * 128 * 4);
  P.gw = (float*)take((size_t)TS * 128 * 4);
  P.biasT = (float*)take((size_t)24 * 129 * 4);
  P.bar = (unsigned*)take((size_t)BAR_TOTAL_WORDS * 4);
  P.WinTtmp = P.Qr;
  P.WpgTtmp = P.Rg;
  P.WqTtmp = P.Rg + (size_t)2048 * 2048;
  P.merged = P.og;
  P.y = (float*)P.Qr;
  P.hb = (u16*)take((size_t)TS * 2048 * 2);
  P.qb = P.AQ;
  P.peb = (u16*)take((size_t)TS * 2048 * 2);
  if (off > ws_size) fprintf(stderr, "workspace too small: need %zu have %zu\n", off, ws_size);
  for (int d = 0; d < 64; ++d) P.ropec[d] = (float)(pow(10000.0, -(double)d / 63.0) / (2.0 * M_PI));

  static int grid_blocks = 0;
  if (!grid_blocks) {
    int dev = 0, cus = 0, per_cu = 0;
    (void)hipGetDevice(&dev);
    (void)hipDeviceGetAttribute(&cus, hipDeviceAttributeMultiprocessorCount, dev);
    (void)hipOccupancyMaxActiveBlocksPerMultiprocessor(&per_cu, fwd_megakernel, NTHR, 0);
    if (per_cu > 2) per_cu = 2;
    if (per_cu < 1) per_cu = 1;
    grid_blocks = cus * per_cu;
  }
  (void)hipMemsetAsync(P.bar, 0, (size_t)BAR_TOTAL_WORDS * 4, stream);
  void* args[] = {&P};
  hipError_t e = hipLaunchCooperativeKernel((void*)fwd_megakernel, dim3(grid_blocks), dim3(NTHR), args, 0, stream);
  if (e != hipSuccess) fprintf(stderr, "cooperative launch failed: %s (grid %d)\n", hipGetErrorString(e), grid_blocks);
}
```
